# Optimizing an MI355X kernel written in HIP

```python
import math
import jax, jax.numpy as jnp
from jax import lax
import numpy as np

D_MODEL = 4096
BATCH = 1
SEQ = 16384
DEPTH = 2

N_MIXERS = 2
ATTN_HEADS = 16
ATTN_HEAD_DIM = D_MODEL // (2 * ATTN_HEADS)
ATTN_V_DIM = 2 * ATTN_HEAD_DIM
ATTN_WIDTH = ATTN_HEADS * ATTN_V_DIM
Q_BLOCK = 128
NUM_BUCKETS = 32
MAX_DISTANCE = 128
POOL_EXPAND = 2
POOL_WIDTH = POOL_EXPAND * D_MODEL
POOL_WINDOWS = (2, 4, 8, 16)
POOL_GROUPS = len(POOL_WINDOWS)
POOL_GROUP_DIM = POOL_WIDTH // POOL_GROUPS
N_ATTN_LAYERS = (DEPTH + 1) // 2
N_POOL_LAYERS = DEPTH // 2
NORM_EPS = 1e-6
SUBLN_EPS = 1e-5
NEG_INF = -1e30

kernel_name = 'hybrid_diffattn_multiscale_pool'


def rmsnorm(x, gain, eps):
    xf = x.astype(jnp.float32)
    inv = lax.rsqrt(jnp.mean(xf * xf, axis=-1, keepdims=True) + eps)
    return (xf * inv * gain.astype(jnp.float32)).astype(x.dtype)


def t5_causal_bucket(n):
    max_exact = NUM_BUCKETS // 2
    nf = jnp.maximum(n, max_exact).astype(jnp.float32)
    large = max_exact + (jnp.log(nf / max_exact) / math.log(MAX_DISTANCE / max_exact)
                         * (NUM_BUCKETS - max_exact)).astype(jnp.int32)
    large = jnp.minimum(large, NUM_BUCKETS - 1)
    return jnp.where(n < max_exact, n, large)


def lambda_init_fn(layer_idx):
    return 0.8 - 0.6 * math.exp(-0.3 * layer_idx)


def diff_attention_branch(h, w_in, lam_params, subln_gain, w_out, rel_bias, layer_idx):
    B, S, _ = h.shape
    n_blocks = S // Q_BLOCK
    proj = h @ w_in
    q, k, v, z = jnp.split(proj, 4, axis=-1)
    q = q.reshape(B, S, ATTN_HEADS, 2, ATTN_HEAD_DIM)
    k = k.reshape(B, S, ATTN_HEADS, 2, ATTN_HEAD_DIM)
    k1 = jnp.transpose(k[..., 0, :], (0, 2, 1, 3))
    k2 = jnp.transpose(k[..., 1, :], (0, 2, 1, 3))
    v = jnp.transpose(v.reshape(B, S, ATTN_HEADS, ATTN_V_DIM), (0, 2, 1, 3))

    def to_blocks(t):
        return jnp.transpose(t.reshape(B, n_blocks, Q_BLOCK, ATTN_HEADS, ATTN_HEAD_DIM), (1, 0, 3, 2, 4))

    q1b = to_blocks(q[..., 0, :])
    q2b = to_blocks(q[..., 1, :])

    lp = lam_params.astype(jnp.float32)
    lam_init = lambda_init_fn(layer_idx)
    lam = jnp.exp(jnp.sum(lp[0] * lp[1])) - jnp.exp(jnp.sum(lp[2] * lp[3])) + lam_init
    scale = ATTN_HEAD_DIM ** -0.5
    k_pos = jnp.arange(S)

    def block_fn(args):
        blk, qa, qb = args
        q_pos = blk * Q_BLOCK + jnp.arange(Q_BLOCK)
        dist = q_pos[:, None] - k_pos[None, :]
        causal = dist >= 0
        bias = jnp.transpose(rel_bias[t5_causal_bucket(jnp.maximum(dist, 0))].astype(jnp.float32), (2, 0, 1))

        def probs(qq, kk):
            logits = jnp.einsum('bhqd,bhkd->bhqk', qq, kk, preferred_element_type=jnp.float32) * scale + bias
            logits = jnp.where(causal, logits, NEG_INF)
            return jax.nn.softmax(logits, axis=-1)

        a = probs(qa, k1) - lam * probs(qb, k2)
        return jnp.einsum('bhqk,bhkd->bhqd', a.astype(v.dtype), v)

    o = lax.map(block_fn, (jnp.arange(n_blocks), q1b, q2b))
    o = jnp.transpose(o, (1, 0, 3, 2, 4)).reshape(B, S, ATTN_HEADS, ATTN_V_DIM)
    o = rmsnorm(o, subln_gain, SUBLN_EPS) * (1.0 - lam_init)
    o = o.reshape(B, S, ATTN_WIDTH) * jax.nn.silu(z)
    return o @ w_out


def pool_branch(h, w_in, w_group, scale, w_out):
    B, S, _ = h.shape
    u, z = jnp.split(h @ w_in, 2, axis=-1)
    ug = u.reshape(B, S, POOL_GROUPS, POOL_GROUP_DIM).astype(jnp.float32)
    cs = lax.cumsum(ug, axis=1)
    t = jnp.arange(S)
    pooled = []
    for g, w in enumerate(POOL_WINDOWS):
        c = cs[:, :, g]
        lag = jnp.pad(c, ((0, 0), (w, 0), (0, 0)))[:, :S]
        cnt = jnp.minimum(t + 1, w).astype(jnp.float32)[None, :, None]
        pooled.append((c - lag) / cnt - ug[:, :, g])
    p = jnp.stack(pooled, axis=2).astype(h.dtype)
    mixed = jnp.einsum('bsgc,gcd->bsgd', p, w_group).reshape(B, S, POOL_WIDTH) * scale
    return (mixed * jax.nn.silu(z)) @ w_out


def setup_inputs(seed: int = 0) -> dict:
    key = jax.random.key(seed)
    ks = jax.random.split(key, 13)
    f32 = jnp.float32
    x = jax.random.normal(ks[0], (BATCH, SEQ, D_MODEL), f32)
    norm_gains = 1.0 + 0.02 * jax.random.normal(ks[1], (DEPTH, D_MODEL), f32)
    final_norm_gain = 1.0 + 0.02 * jax.random.normal(ks[2], (D_MODEL,), f32)
    rel_bias = 0.2 * jax.random.normal(ks[3], (NUM_BUCKETS, ATTN_HEADS), f32)
    attn_w_in = jax.random.normal(ks[4], (N_ATTN_LAYERS, D_MODEL, 4 * ATTN_WIDTH), f32) * D_MODEL ** -0.5
    attn_lambda = 0.1 * jax.random.normal(ks[5], (N_ATTN_LAYERS, 4, ATTN_HEAD_DIM), f32)
    attn_subln_gain = 1.0 + 0.02 * jax.random.normal(ks[6], (N_ATTN_LAYERS, ATTN_V_DIM), f32)
    attn_w_out = jax.random.normal(ks[7], (N_ATTN_LAYERS, ATTN_WIDTH, D_MODEL), f32) * ATTN_WIDTH ** -0.5
    pool_w_in = jax.random.normal(ks[8], (N_POOL_LAYERS, D_MODEL, 2 * POOL_WIDTH), f32) * D_MODEL ** -0.5
    pool_w_group = jax.random.normal(ks[9], (N_POOL_LAYERS, POOL_GROUPS, POOL_GROUP_DIM, POOL_GROUP_DIM), f32) * POOL_GROUP_DIM ** -0.5
    pool_scale = 1.0 + 0.02 * jax.random.normal(ks[10], (N_POOL_LAYERS, POOL_WIDTH), f32)
    pool_w_out = jax.random.normal(ks[11], (N_POOL_LAYERS, POOL_WIDTH, D_MODEL), f32) * POOL_WIDTH ** -0.5
    return {'x': x, 'norm_gains': norm_gains, 'final_norm_gain': final_norm_gain, 'rel_bias': rel_bias,
            'attn_w_in': attn_w_in, 'attn_lambda': attn_lambda, 'attn_subln_gain': attn_subln_gain,
            'attn_w_out': attn_w_out, 'pool_w_in': pool_w_in, 'pool_w_group': pool_w_group,
            'pool_scale': pool_scale, 'pool_w_out': pool_w_out}


def reference(x, norm_gains, final_norm_gain, rel_bias, attn_w_in, attn_lambda, attn_subln_gain,
              attn_w_out, pool_w_in, pool_w_group, pool_scale, pool_w_out):
    for i in range(DEPTH):
        h = rmsnorm(x, norm_gains[i], NORM_EPS)
        j = i // N_MIXERS
        if i % N_MIXERS == 0:
            y = diff_attention_branch(h, attn_w_in[j], attn_lambda[j], attn_subln_gain[j],
                                      attn_w_out[j], rel_bias, i)
        else:
            y = pool_branch(h, pool_w_in[j], pool_w_group[j], pool_scale[j], pool_w_out[j])
        x = x + y
    return rmsnorm(x, final_norm_gain, NORM_EPS)
```

```cpp
#include <hip/hip_runtime.h>
#include <cstdio>
#include <cstdint>
#include <cmath>
namespace pg8 {
#define PG8_LAS __attribute__((address_space(3)))
typedef unsigned short bf16_t;
typedef short bf16x8 __attribute__((ext_vector_type(8)));
typedef float f32x4 __attribute__((ext_vector_type(4)));
typedef unsigned u32x4 __attribute__((ext_vector_type(4)));
constexpr int BM = 256, BK = 64, HALF = 128, HTB = HALF * BK * 2  , STAGE_BYTES = 8 * HTB, NXCD = 8, WGM = 8;

__host__ __device__ __forceinline__ int lds_byte(int r, int c) { const int st = (r >> 4) * 2 + (c >> 5), rr = r & 15, cc = c & 31, ob = rr * 64 + cc * 2; return st * 1024 + (ob ^ (((ob >> 9) & 1) << 5)); }
__host__ __device__ __forceinline__ void stage_rc(int b, int& R, int& C) { const int st = b / 1024, sb = b % 1024, swz = sb ^ (((sb >> 9) & 1) << 5); R = (st >> 1) * 16 + swz / 64; C = (st & 1) * 32 + (swz % 64) / 2; }
__host__ __device__ __forceinline__ int perm32(int rho) { const int n = rho >> 4, i = rho & 15; return 8 * (i >> 2) + 4 * n + (i & 3); }

struct Unit { int pm, pn; };
struct Gemm { const bf16_t* A; const bf16_t* Bt; int M, N, K, lda, ldb, gshift, gstride;
    __device__ __forceinline__ size_t aoff(int pn) const { return gshift >= 0 ? (size_t)(pn >> gshift) * (size_t)gstride : (size_t)0; } };

struct StaticOrder {
    int nM, nN, nwg, G, c;
    __host__ __device__ void init(int M, int N, int G_, int c_) { nM = M / BM; nN = N / BM; nwg = nM * nN; G = G_; c = c_; }
    __host__ __device__ bool next(int i, Unit& u) const {
        const long L = (long)i * G + c; if (L >= nwg) return false;
        int wgid = (int)L; { const int q = nwg / NXCD, r = nwg % NXCD, xcd = wgid % NXCD, off = wgid / NXCD; wgid = (xcd < r ? xcd * (q + 1) : r * (q + 1) + (xcd - r) * q) + off; }
        const int nig = WGM * nN, gid = wgid / nig, fm = gid * WGM, gsz = (nM - fm) < WGM ? (nM - fm) : WGM;
        u.pm = fm + ((wgid % nig) % gsz); u.pn = (wgid % nig) / gsz; return true;
    }
    __device__ __forceinline__ void a_ready(const Unit&) const {}
    __device__ __forceinline__ void done(const Unit&) const {}
};

__device__ __forceinline__ unsigned cvt_pk_bf16(float lo, float hi) { unsigned r; asm volatile("v_cvt_pk_bf16_f32 %0, %1, %2" : "=v"(r) : "v"(lo), "v"(hi)); return r; }
typedef float f32x2 __attribute__((ext_vector_type(2)));
template <class Epi, class Sched, bool ALIGN_EPI = false, bool SP2 = false>
__device__ __forceinline__ void gemm_phase(PG8_LAS unsigned char* lds, const Gemm g, const Sched& S, const Epi& E) {
    const int tid = threadIdx.x, wid = __builtin_amdgcn_readfirstlane(tid >> 6), lane = tid & 63, wr = wid >> 2, wc = wid & 3, fr = lane & 15, fq = lane >> 4;
    const int K = g.K, nt = K / BK;
    unsigned voffA[2], voffB[2];
#pragma unroll
    for (int i = 0; i < 2; ++i) { int R, C; stage_rc(tid * 16 + i * 8192, R, C); const int Rb = Epi::PERM ? ((R & ~31) + perm32(R & 31)) : R;
        voffA[i] = (unsigned)(R * g.lda + C) * 2u; voffB[i] = (unsigned)(Rb * g.ldb + C) * 2u; }
    const size_t kstep = (size_t)(BK * 2);
    const size_t hstepA = (size_t)HALF * g.lda * 2, hstepB = (size_t)HALF * g.ldb * 2;
    const size_t tstepA = 2 * hstepA, tstepB = 2 * hstepB;
    const unsigned ldsw = (unsigned)wid * 1024u;
    const int aoff = lds_byte(wr * 64 + fr, fq * 8), boff = lds_byte(wc * 32 + fr, fq * 8);
#define PG8_SA(b, h) (((b) * 2 + (h)) * HTB)
#define PG8_SB(b, h) ((4 + (b) * 2 + (h)) * HTB)
#define PG8_STAGE(bufoff, gbase, voff) do { _Pragma("unroll") for (int _i = 0; _i < 2; ++_i) \
        __builtin_amdgcn_global_load_lds((const unsigned*)((const char*)(gbase) + (voff)[_i]), (PG8_LAS unsigned*)(lds + (bufoff) + ldsw + _i * 8192), 16, 0, 0); } while (0)
#define PG8_LDA(dst, b, h) do { _Pragma("unroll") for (int m = 0; m < 4; ++m) _Pragma("unroll") for (int k = 0; k < 2; ++k) dst[m][k] = *(const PG8_LAS bf16x8*)(lds + PG8_SA(b, h) + aoff + m * 2048 + k * 1024); } while (0)
#define PG8_LDB(dst, b, h) do { _Pragma("unroll") for (int n = 0; n < 2; ++n) _Pragma("unroll") for (int k = 0; k < 2; ++k) dst[n][k] = *(const PG8_LAS bf16x8*)(lds + PG8_SB(b, h) + boff + n * 2048 + k * 1024); } while (0)
#define PG8_MMA(ai, bj, At, Bt) do { __builtin_amdgcn_s_setprio(1); _Pragma("unroll") for (int m = 0; m < 4; ++m) _Pragma("unroll") for (int n = 0; n < 2; ++n) _Pragma("unroll") for (int k = 0; k < 2; ++k) \
        acc[ai][bj][m][n] = __builtin_amdgcn_mfma_f32_16x16x32_bf16(Bt[n][k], At[m][k], acc[ai][bj][m][n], 0, 0, 0); __builtin_amdgcn_s_setprio(0); } while (0)
#define PG8_WAIT_V(n) asm volatile("s_waitcnt vmcnt(" #n ")" ::: "memory")
#define PG8_WAIT_L(n) asm volatile("s_waitcnt lgkmcnt(" #n ")" ::: "memory")
#define PG8_BAR __builtin_amdgcn_s_barrier()
#define PG8_SCHED __builtin_amdgcn_sched_barrier(0)
    Unit cur, nxt; int ui = 0;
    if (!S.next(0, cur)) return;
    f32x4 acc[2][2][4][2];
#pragma unroll
    for (int a = 0; a < 2; ++a)
#pragma unroll
        for (int b = 0; b < 2; ++b)
#pragma unroll
            for (int m = 0; m < 4; ++m)
#pragma unroll
                for (int n = 0; n < 2; ++n) acc[a][b][m][n] = (f32x4){0.f, 0.f, 0.f, 0.f};
    bf16x8 At[4][2], B0[2][2], B1[2][2];
    const char* cA = (const char*)g.A + (size_t)cur.pm * tstepA + g.aoff(cur.pn); const char* cB = (const char*)g.Bt + (size_t)cur.pn * tstepB;
    S.a_ready(cur);
    if constexpr (SP2) {
        PG8_STAGE(PG8_SB(0, 0), cB, voffB); PG8_STAGE(PG8_SB(0, 1), cB + hstepB, voffB); PG8_STAGE(PG8_SA(0, 0), cA, voffA); PG8_STAGE(PG8_SA(0, 1), cA + hstepA, voffA);
        if (wr == 1) PG8_BAR;
        PG8_WAIT_V(2); PG8_BAR;
        PG8_STAGE(PG8_SB(1, 0), cB + kstep, voffB); PG8_STAGE(PG8_SA(1, 0), cA + kstep, voffA); PG8_STAGE(PG8_SB(1, 1), cB + hstepB + kstep, voffB);
        PG8_WAIT_V(6); PG8_BAR;
    } else {
        PG8_STAGE(PG8_SB(0, 0), cB, voffB); PG8_STAGE(PG8_SA(0, 0), cA, voffA); PG8_STAGE(PG8_SB(0, 1), cB + hstepB, voffB); PG8_STAGE(PG8_SA(0, 1), cA + hstepA, voffA);
        if (wr == 1) PG8_BAR;
        PG8_WAIT_V(4); PG8_BAR;
        PG8_STAGE(PG8_SB(1, 0), cB + kstep, voffB); PG8_STAGE(PG8_SA(1, 0), cA + kstep, voffA); PG8_STAGE(PG8_SB(1, 1), cB + hstepB + kstep, voffB);
        PG8_WAIT_V(6); PG8_BAR;
    }
    for (;;) {
        const bool has_next = S.next(ui + 1, nxt);
        const char* nA = has_next ? (const char*)g.A + (size_t)nxt.pm * tstepA + g.aoff(nxt.pn) : cA; const char* nB = has_next ? (const char*)g.Bt + (size_t)nxt.pn * tstepB : cB;
        for (int t = 0; t < nt; t += 2) {
            const bool last = (t == nt - 2);
            const char* a1 = cA + (size_t)(t + 1) * kstep;
            const char* a2 = last ? nA : cA + (size_t)(t + 2) * kstep; const char* b2 = last ? nB : cB + (size_t)(t + 2) * kstep;
            const char* a3 = a2 + kstep; const char* b3 = b2 + kstep;
            if (last && has_next) S.a_ready(nxt);
            if constexpr (SP2) {
            PG8_LDB(B0, 0, 0); PG8_LDB(B1, 0, 1); PG8_SCHED; PG8_LDA(At, 0, 0); PG8_STAGE(PG8_SA(1, 1), a1 + hstepA, voffA);
            PG8_WAIT_V(8); PG8_WAIT_L(0); PG8_BAR; PG8_MMA(0, 0, At, B0); PG8_MMA(0, 1, At, B1); PG8_BAR; PG8_SCHED;
            PG8_LDA(At, 0, 1); PG8_STAGE(PG8_SB(0, 0), b2, voffB); PG8_STAGE(PG8_SB(0, 1), b2 + hstepB, voffB); PG8_STAGE(PG8_SA(0, 0), a2, voffA);
            PG8_WAIT_V(8); PG8_WAIT_L(0); PG8_BAR; PG8_MMA(1, 0, At, B0); PG8_MMA(1, 1, At, B1); PG8_BAR; PG8_SCHED;
            PG8_LDB(B0, 1, 0); PG8_LDB(B1, 1, 1); PG8_SCHED; PG8_LDA(At, 1, 0); PG8_STAGE(PG8_SA(0, 1), a2 + hstepA, voffA);
            PG8_WAIT_V(8); PG8_WAIT_L(0); PG8_BAR; PG8_MMA(0, 0, At, B0); PG8_MMA(0, 1, At, B1); PG8_BAR; PG8_SCHED;
            PG8_LDA(At, 1, 1); PG8_STAGE(PG8_SB(1, 0), b3, voffB); PG8_STAGE(PG8_SB(1, 1), b3 + hstepB, voffB); PG8_STAGE(PG8_SA(1, 0), a3, voffA);
            PG8_WAIT_V(8); PG8_WAIT_L(0); PG8_BAR; PG8_MMA(1, 0, At, B0); PG8_MMA(1, 1, At, B1); PG8_BAR; PG8_SCHED;
            } else {
            PG8_LDB(B0, 0, 0); PG8_SCHED; PG8_LDA(At, 0, 0); PG8_STAGE(PG8_SA(1, 1), a1 + hstepA, voffA);
            PG8_WAIT_L(8); PG8_BAR; PG8_WAIT_L(0); PG8_MMA(0, 0, At, B0); PG8_BAR; PG8_SCHED;
            PG8_LDB(B1, 0, 1); PG8_STAGE(PG8_SB(0, 0), b2, voffB);
            PG8_BAR; PG8_WAIT_L(0); PG8_MMA(0, 1, At, B1); PG8_BAR;
            PG8_LDA(At, 0, 1); PG8_STAGE(PG8_SA(0, 0), a2, voffA);
            PG8_BAR; PG8_WAIT_L(0); PG8_MMA(1, 0, At, B0); PG8_BAR; PG8_SCHED;
            PG8_STAGE(PG8_SB(0, 1), b2 + hstepB, voffB);
            PG8_WAIT_V(6); PG8_BAR; PG8_MMA(1, 1, At, B1); PG8_BAR;
            PG8_LDB(B0, 1, 0); PG8_SCHED; PG8_LDA(At, 1, 0); PG8_STAGE(PG8_SA(0, 1), a2 + hstepA, voffA);
            PG8_WAIT_L(8); PG8_BAR; PG8_WAIT_L(0); PG8_MMA(0, 0, At, B0); PG8_BAR; PG8_SCHED;
            PG8_LDB(B1, 1, 1); PG8_STAGE(PG8_SB(1, 0), b3, voffB);
            PG8_BAR; PG8_WAIT_L(0); PG8_MMA(0, 1, At, B1); PG8_BAR;
            PG8_LDA(At, 1, 1); PG8_STAGE(PG8_SA(1, 0), a3, voffA);
            PG8_BAR; PG8_WAIT_L(0); PG8_MMA(1, 0, At, B0); PG8_BAR; PG8_SCHED;
            PG8_STAGE(PG8_SB(1, 1), b3 + hstepB, voffB);
            PG8_WAIT_V(6); PG8_BAR; PG8_MMA(1, 1, At, B1); PG8_BAR;
            }
        }
        if constexpr (ALIGN_EPI) { if (wr == 0) PG8_BAR; }
        if constexpr (!Epi::AFTER_DRAIN) { E(acc, cur, wr, wc, fr, fq); S.done(cur); }
        if (!has_next) break;
#pragma unroll
        for (int a = 0; a < 2; ++a)
#pragma unroll
            for (int b = 0; b < 2; ++b)
#pragma unroll
                for (int m = 0; m < 4; ++m)
#pragma unroll
                    for (int n = 0; n < 2; ++n) acc[a][b][m][n] = (f32x4){0.f, 0.f, 0.f, 0.f};
        cur = nxt; cA = nA; cB = nB; ++ui;
        if constexpr (ALIGN_EPI) { if (wr == 1) PG8_BAR; }
    }
    PG8_WAIT_V(0);
    if constexpr (!ALIGN_EPI) { if (wr == 0) PG8_BAR; }
    PG8_BAR;
    if constexpr (Epi::AFTER_DRAIN) { E.fused(acc, cur, wr, wc, fr, fq, lds, wid, lane); S.done(cur); }
#undef PG8_SA
#undef PG8_SB
#undef PG8_STAGE
#undef PG8_LDA
#undef PG8_LDB
#undef PG8_MMA
#undef PG8_WAIT_V
#undef PG8_WAIT_L
#undef PG8_BAR
#undef PG8_SCHED
}
}
namespace pg8 {
__device__ __forceinline__ u32x4 pack8_bf16(const f32x4 v0, const f32x4 v1) { u32x4 w; w.x = cvt_pk_bf16(v0[0], v0[1]); w.y = cvt_pk_bf16(v0[2], v0[3]); w.z = cvt_pk_bf16(v1[0], v1[1]); w.w = cvt_pk_bf16(v1[2], v1[3]); return w; }

struct EpiNormSplit {
    static constexpr bool PERM = true, AFTER_DRAIN = false;
    bf16_t* O; const float* ss; int split_cols; size_t split_stride; float scale0; float eps;
    __device__ __forceinline__ void operator()(const f32x4 (&acc)[2][2][4][2], const Unit& u, int wr, int wc, int fr, int fq) const {
        const int row0 = u.pm * BM + wr * 64 + fr; int colt = u.pn * BM; bf16_t* base = O;
        const int t = colt / split_cols; base += (size_t)t * split_stride; colt -= t * split_cols;
        const float sc = (t == 0) ? scale0 : 1.f;
        const int col0 = colt + wc * 32 + 8 * fq;
#pragma unroll
        for (int ai = 0; ai < 2; ++ai)
#pragma unroll
            for (int m = 0; m < 4; ++m) { const int row = row0 + ai * HALF + m * 16;
                const float rs = sc / sqrtf(ss[row] * (1.0f / 4096.0f) + eps);
                bf16_t* rowp = base + (size_t)row * split_cols + col0;
#pragma unroll
                for (int bj = 0; bj < 2; ++bj) { const f32x4 v0 = acc[ai][bj][m][0] * rs, v1 = acc[ai][bj][m][1] * rs; *(u32x4*)(rowp + bj * HALF) = pack8_bf16(v0, v1); } }
    }
};

struct EpiResid {
    static constexpr bool PERM = true, AFTER_DRAIN = false;
    const float* base; float* out; bf16_t* xb; float* ss; int ldc;
    __device__ __forceinline__ void operator()(const f32x4 (&acc)[2][2][4][2], const Unit& u, int wr, int wc, int fr, int fq) const {
        const int row0 = u.pm * BM + wr * 64 + fr, col0 = u.pn * BM + wc * 32 + 8 * fq;
#pragma unroll
        for (int ai = 0; ai < 2; ++ai)
#pragma unroll
            for (int m = 0; m < 4; ++m) { const int row = row0 + ai * HALF + m * 16; const size_t off = (size_t)row * ldc + col0; float sq = 0.f;
#pragma unroll
                for (int bj = 0; bj < 2; ++bj) { const float* bp = base + off + bj * HALF; const f32x4 b0 = *(const f32x4*)bp, b1 = *(const f32x4*)(bp + 4);
                    const f32x4 v0 = acc[ai][bj][m][0] + b0, v1 = acc[ai][bj][m][1] + b1;
                    *(f32x4*)(out + off + bj * HALF) = v0; *(f32x4*)(out + off + bj * HALF + 4) = v1;
                    sq += (v0[0] * v0[0] + v0[1] * v0[1]) + (v0[2] * v0[2] + v0[3] * v0[3]) + (v1[0] * v1[0] + v1[1] * v1[1]) + (v1[2] * v1[2] + v1[3] * v1[3]);
                    if (xb) *(u32x4*)(xb + off + bj * HALF) = pack8_bf16(v0, v1); }
                sq += __shfl_xor(sq, 16); sq += __shfl_xor(sq, 32);
                if (fq == 0) unsafeAtomicAdd(ss + row, sq); }
    }
};

struct EpiPoolMix {
    static constexpr bool PERM = true, AFTER_DRAIN = false;
    bf16_t* O; const bf16_t* Z; const float* pscale; int ldc;
    __device__ __forceinline__ float silu(float z) const { return z * __builtin_amdgcn_rcpf(1.0f + __builtin_amdgcn_exp2f(-1.4426950408889634f * z)); }
    __device__ __forceinline__ void operator()(const f32x4 (&acc)[2][2][4][2], const Unit& u, int wr, int wc, int fr, int fq) const {
        const int row0 = u.pm * BM + wr * 64 + fr, col0 = u.pn * BM + wc * 32 + 8 * fq;
        f32x4 ps[2][2];
#pragma unroll
        for (int bj = 0; bj < 2; ++bj)
#pragma unroll
            for (int n = 0; n < 2; ++n) ps[bj][n] = *(const f32x4*)(pscale + col0 + bj * HALF + 4 * n);
#pragma unroll
        for (int ai = 0; ai < 2; ++ai)
#pragma unroll
            for (int m = 0; m < 4; ++m) { const int row = row0 + ai * HALF + m * 16; const size_t off = (size_t)row * ldc + col0;
#pragma unroll
                for (int bj = 0; bj < 2; ++bj) { const u32x4 zz = *(const u32x4*)(Z + off + bj * HALF);
                    f32x4 z0, z1;
                    z0[0] = __uint_as_float(zz.x << 16); z0[1] = __uint_as_float(zz.x & 0xffff0000u); z0[2] = __uint_as_float(zz.y << 16); z0[3] = __uint_as_float(zz.y & 0xffff0000u);
                    z1[0] = __uint_as_float(zz.z << 16); z1[1] = __uint_as_float(zz.z & 0xffff0000u); z1[2] = __uint_as_float(zz.w << 16); z1[3] = __uint_as_float(zz.w & 0xffff0000u);
                    f32x4 v0 = acc[ai][bj][m][0] * ps[bj][0], v1 = acc[ai][bj][m][1] * ps[bj][1];
#pragma unroll
                    for (int e = 0; e < 4; ++e) { v0[e] *= silu(z0[e]); v1[e] *= silu(z1[e]); }
                    *(u32x4*)(O + off + bj * HALF) = pack8_bf16(v0, v1); } }
    }
};
}
namespace dattn {
#define DA_LAS __attribute__((address_space(3)))
typedef unsigned short bf16_t;
typedef short bf16x8 __attribute__((ext_vector_type(8)));
typedef short s16x4 __attribute__((ext_vector_type(4)));
typedef float f32x16 __attribute__((ext_vector_type(16)));
typedef float f32x4 __attribute__((ext_vector_type(4)));
typedef unsigned u32x4 __attribute__((ext_vector_type(4)));
constexpr int PITCH = 4096;
constexpr int STAGE = 65536, OFF_V = 32768;
constexpr int OFF_TBL = 131072, OFF_WS = OFF_TBL + 512, LDS_END = OFF_WS + 8 * 256;
constexpr float LOG2E = 1.4426950408889634f;
constexpr float THR = 8.0f;
constexpr float QSCALE = 0.08838834764831845f * LOG2E;

__device__ __forceinline__ int crow(int r, int hi) { return (r & 3) + 8 * (r >> 2) + 4 * hi; }
__device__ __forceinline__ unsigned cvtpk(float lo, float hi) { unsigned r; asm volatile("v_cvt_pk_bf16_f32 %0, %1, %2" : "=v"(r) : "v"(lo), "v"(hi)); return r; }
__device__ __forceinline__ int v_rd_base(int lane) { return ((lane & 3) << 3) | (((lane >> 2) & 3) << 6) | (((lane >> 4) & 1) << 5) | (((lane >> 5) & 1) << 8); }
__device__ __forceinline__ float silu(float z) { return z * __builtin_amdgcn_rcpf(1.0f + __builtin_amdgcn_exp2f(-LOG2E * z)); }

struct Tensors { const bf16_t* Q; const bf16_t* K; const bf16_t* V; const bf16_t* Z; bf16_t* O; const float* rel_bias; const float* subln; };

#define DA_WAIT_BAR() asm volatile("s_waitcnt vmcnt(0) lgkmcnt(0)\n\ts_barrier" ::: "memory")
#define DA_SBAR() __builtin_amdgcn_sched_barrier(0)

template <int ST>
__device__ __forceinline__ void tile(DA_LAS unsigned char* lds, int tt, int qw, int r32, int hi, int kbase, int vb, const bf16x8 (&qr)[8], f32x16 (&o)[8], float& m_reg, float& l_reg,
                                     DA_LAS float* wsf, const DA_LAS float* tbl) {
    const int k0 = tt * 64;
    asm volatile("" : "+v"(kbase), "+v"(vb));
    f32x16 p0 = {}, p1 = {};
#pragma unroll
    for (int d0 = 0; d0 < 8; ++d0) { const int a = ST * STAGE + (kbase ^ (d0 << 5));
        const bf16x8 b0 = *(const DA_LAS bf16x8*)(lds + a), b1 = *(const DA_LAS bf16x8*)(lds + a + 8192);
        p0 = __builtin_amdgcn_mfma_f32_32x32x16_bf16(b0, qr[d0], p0, 0, 0, 0);
        p1 = __builtin_amdgcn_mfma_f32_32x32x16_bf16(b1, qr[d0], p1, 0, 0, 0); }
    if (k0 + 176 > qw) {
        const float NEG = -__builtin_inff(); const int dq = qw + r32 - k0 - 4 * hi;
#pragma unroll
        for (int r = 0; r < 16; ++r) { const int c = (r & 3) + 8 * (r >> 2); const int d_0 = dq - c, d_1 = d_0 - 32;
            const int i0 = d_0 < 0 ? 0 : (d_0 > 127 ? 127 : d_0), i1 = d_1 < 0 ? 0 : (d_1 > 127 ? 127 : d_1);
            const float b_0 = tbl[i0], b_1 = tbl[i1];
            p0[r] = d_0 < 0 ? NEG : p0[r] + b_0; p1[r] = d_1 < 0 ? NEG : p1[r] + b_1; }
    }
    float pmax = p0[0];
#pragma unroll
    for (int r = 1; r < 16; ++r) pmax = fmaxf(pmax, p0[r]);
#pragma unroll
    for (int r = 0; r < 16; ++r) pmax = fmaxf(pmax, p1[r]);
    { auto rr = __builtin_amdgcn_permlane32_swap(__float_as_uint(pmax), __float_as_uint(pmax), false, false); pmax = fmaxf(__uint_as_float(rr[0]), __uint_as_float(rr[1])); }
    if (!__all(pmax - m_reg <= THR)) {
        const float mn = fmaxf(m_reg, pmax); const float alpha = __builtin_amdgcn_exp2f(m_reg - mn); m_reg = mn; l_reg *= alpha;
        if (hi == 0) wsf[r32] = alpha;
        asm volatile("s_waitcnt lgkmcnt(0)" ::: "memory");
        float al[16];
#pragma unroll
        for (int r = 0; r < 16; ++r) al[r] = wsf[crow(r, hi)];
#pragma unroll
        for (int d0 = 0; d0 < 8; ++d0)
#pragma unroll
            for (int r = 0; r < 16; ++r) o[d0][r] *= al[r];
    }
    float ps = 0.f;
#pragma unroll
    for (int r = 0; r < 16; ++r) { p0[r] = __builtin_amdgcn_exp2f(p0[r] - m_reg); ps += p0[r]; }
#pragma unroll
    for (int r = 0; r < 16; ++r) { p1[r] = __builtin_amdgcn_exp2f(p1[r] - m_reg); ps += p1[r]; }
    l_reg += ps;
    bf16x8 pa0, pa1, pa2, pa3;
#define DA_PK4(P, B_, OUT) do { const unsigned a0 = cvtpk(P[B_ + 0], P[B_ + 1]), a1 = cvtpk(P[B_ + 2], P[B_ + 3]); \
        const unsigned b0 = cvtpk(P[B_ + 4], P[B_ + 5]), b1 = cvtpk(P[B_ + 6], P[B_ + 7]); \
        auto r0 = __builtin_amdgcn_permlane32_swap(a0, b0, false, false); auto r1 = __builtin_amdgcn_permlane32_swap(a1, b1, false, false); \
        u32x4 w = {r0[0], r1[0], r0[1], r1[1]}; OUT = __builtin_bit_cast(bf16x8, w); } while (0)
    DA_PK4(p0, 0, pa0); DA_PK4(p0, 8, pa1); DA_PK4(p1, 0, pa2); DA_PK4(p1, 8, pa3);
#undef DA_PK4
    const int vbs = vb + ST * STAGE;
#define DA_TRRD(dst, off) asm volatile("ds_read_b64_tr_b16 %0, %1 offset:%2" : "=&v"(dst) : "v"(vbs), "i"(off) : "memory")
#define DA_PV(d0) do { s16x4 l0, l1, l2, l3, h0, h1, h2, h3; constexpr int b_ = (d0) * 512; \
        DA_TRRD(l0, b_); DA_TRRD(h0, b_ + 4096); DA_TRRD(l1, b_ + 8192); DA_TRRD(h1, b_ + 12288); DA_TRRD(l2, b_ + 16384); DA_TRRD(h2, b_ + 20480); DA_TRRD(l3, b_ + 24576); DA_TRRD(h3, b_ + 28672); \
        asm volatile("s_waitcnt lgkmcnt(0)" ::: "memory"); DA_SBAR(); \
        o[d0] = __builtin_amdgcn_mfma_f32_32x32x16_bf16(pa0, (bf16x8){l0[0], l0[1], l0[2], l0[3], h0[0], h0[1], h0[2], h0[3]}, o[d0], 0, 0, 0); \
        o[d0] = __builtin_amdgcn_mfma_f32_32x32x16_bf16(pa1, (bf16x8){l1[0], l1[1], l1[2], l1[3], h1[0], h1[1], h1[2], h1[3]}, o[d0], 0, 0, 0); \
        o[d0] = __builtin_amdgcn_mfma_f32_32x32x16_bf16(pa2, (bf16x8){l2[0], l2[1], l2[2], l2[3], h2[0], h2[1], h2[2], h2[3]}, o[d0], 0, 0, 0); \
        o[d0] = __builtin_amdgcn_mfma_f32_32x32x16_bf16(pa3, (bf16x8){l3[0], l3[1], l3[2], l3[3], h3[0], h3[1], h3[2], h3[3]}, o[d0], 0, 0, 0); } while (0)
    DA_PV(0); DA_PV(1); DA_PV(2); DA_PV(3); DA_PV(4); DA_PV(5); DA_PV(6); DA_PV(7);
#undef DA_PV
#undef DA_TRRD
}

__device__ __forceinline__ void attn_unit(int h, int qb, const Tensors& T, float lam, DA_LAS unsigned char* lds) {
    const int tid = threadIdx.x, lane = tid & 63, r32 = lane & 31, hi = lane >> 5;
    const int wid = __builtin_amdgcn_readfirstlane(tid >> 6), rb = wid & 3, sh = wid >> 2;
    const int q0 = qb * 128, qw = q0 + rb * 32;
    const int NT = 2 * (qb + 1);
    const int ntw = (qw + 31) / 64 + 1;
    DA_LAS float* tbl = (DA_LAS float*)(lds + OFF_TBL);
    DA_LAS float* wsf = (DA_LAS float*)(lds + OFF_WS) + wid * 64;
    if (tid < 128) {
        const int n = tid; int bucket = n;
        if (n >= 16) { const float v = logf((float)n / 16.0f) / 2.0794415416798357f * 16.0f; const int lg = 16 + (int)v; bucket = lg < 31 ? lg : 31; }
        tbl[n] = (T.rel_bias[bucket * 16 + h] - T.rel_bias[31 * 16 + h]) * LOG2E;
    }
    const bool isK = wid < 4; const int wv = wid - 4;
    const unsigned laneK = (unsigned)((lane >> 4) * 8192 + (((lane & 15) ^ (lane >> 4)) << 4));
    const unsigned laneV = (unsigned)((8 * ((lane >> 4) & 1) + ((lane >> 2) & 3)) * 8192 + (lane >> 5) * 64 + (lane & 3) * 16);
    const unsigned laneoff = isK ? laneK : laneV;
    const char* gsrc = isK ? (const char*)T.K + (size_t)h * 512 + (size_t)(wid >> 1) * 256 + (size_t)((wid & 1) * 32) * 8192
                           : (const char*)T.V + (size_t)h * 512 + (size_t)(16 * wv) * 8192;
    const int dst0 = isK ? (wid >> 1) * 16384 + (wid & 1) * 8192 : OFF_V + wv * 8192;
#define DA_DMA(t_, st_) do { _Pragma("unroll") for (int i_ = 0; i_ < 8; ++i_) { \
        const unsigned uo_ = isK ? (unsigned)(i_ * 32768) : (unsigned)((i_ >> 2) * 32768 + (i_ & 3) * 128); \
        const unsigned long long ub_ = (unsigned long long)(gsrc + (size_t)(t_) * (64 * 8192) + uo_); \
        const char* ubp_ = (const char*)(((unsigned long long)(unsigned)__builtin_amdgcn_readfirstlane((int)(ub_ >> 32)) << 32) | (unsigned long long)(unsigned)__builtin_amdgcn_readfirstlane((int)ub_)); \
        const unsigned lo_ = laneoff ^ (isK ? (unsigned)((i_ & 3) << 6) : 0u); \
        __builtin_amdgcn_global_load_lds((const unsigned*)(ubp_ + lo_), (DA_LAS unsigned*)(lds + (st_) * STAGE + dst0 + i_ * 1024), 16, 0, 0); } } while (0)
    DA_DMA(0, 0);
    const bf16_t* Qw = T.Q + (size_t)(qw + r32) * PITCH + h * 256 + sh * 128 + hi * 8;
    bf16x8 qr[8];
#pragma unroll
    for (int d0 = 0; d0 < 8; ++d0) qr[d0] = *(const bf16x8*)(Qw + d0 * 16);
    const int kbase = sh * 16384 + r32 * 256 + (((r32 & 15) ^ hi) << 4);
    const int vb = (int)(uintptr_t)lds + OFF_V + v_rd_base(lane);
    float m_reg = -1e30f, l_reg = 0.f;
    f32x16 o[8];
#pragma unroll
    for (int d0 = 0; d0 < 8; ++d0) o[d0] = f32x16{};
    for (int t = 0; t < NT; t += 2) {
        DA_WAIT_BAR();
        DA_DMA(t + 1, 1);
        if (t < ntw) tile<0>(lds, t, qw, r32, hi, kbase, vb, qr, o, m_reg, l_reg, wsf, tbl);
        DA_WAIT_BAR();
        if (t + 2 < NT) DA_DMA(t + 2, 0);
        if (t + 1 < ntw) tile<1>(lds, t + 1, qw, r32, hi, kbase, vb, qr, o, m_reg, l_reg, wsf, tbl);
    }
#undef DA_DMA
    { auto rr = __builtin_amdgcn_permlane32_swap(__float_as_uint(l_reg), __float_as_uint(l_reg), false, false); l_reg = __uint_as_float(rr[0]) + __uint_as_float(rr[1]); }
    if (hi == 0) wsf[r32] = 1.0f / l_reg;
    asm volatile("s_waitcnt lgkmcnt(0)" ::: "memory");
    float rli[16];
#pragma unroll
    for (int r = 0; r < 16; ++r) rli[r] = wsf[crow(r, hi)];
#pragma unroll
    for (int d0 = 0; d0 < 8; ++d0)
#pragma unroll
        for (int r = 0; r < 16; ++r) o[d0][r] *= rli[r];
    DA_WAIT_BAR();
    DA_LAS f32x4* X4 = (DA_LAS f32x4*)(lds + rb * 32768);
    if (sh == 1) { const float nl = -lam;
#pragma unroll
        for (int d0 = 0; d0 < 8; ++d0) {
#pragma unroll
            for (int j = 0; j < 4; ++j) { f32x4 v; v[0] = o[d0][4 * j] * nl; v[1] = o[d0][4 * j + 1] * nl; v[2] = o[d0][4 * j + 2] * nl; v[3] = o[d0][4 * j + 3] * nl;
                X4[(d0 * 4 + j) * 64 + lane] = v; }
            DA_SBAR(); }
    }
    DA_WAIT_BAR();
    if (sh == 0) {
#pragma unroll
        for (int d0 = 0; d0 < 8; ++d0)
#pragma unroll
            for (int j = 0; j < 4; ++j) { const f32x4 v = X4[(d0 * 4 + j) * 64 + lane]; o[d0][4 * j] += v[0]; o[d0][4 * j + 1] += v[1]; o[d0][4 * j + 2] += v[2]; o[d0][4 * j + 3] += v[3]; if (j == 3) DA_SBAR(); }
        float rs[16];
#pragma unroll
        for (int r = 0; r < 16; ++r) { float s = 0.f;
#pragma unroll
            for (int d0 = 0; d0 < 8; ++d0) s += o[d0][r] * o[d0][r];
            s += __shfl_xor(s, 1); s += __shfl_xor(s, 2); s += __shfl_xor(s, 4); s += __shfl_xor(s, 8); s += __shfl_xor(s, 16);
            rs[r] = 0.8f / sqrtf(s * (1.0f / 256.0f) + 1e-5f); }
        float gn[8];
#pragma unroll
        for (int d0 = 0; d0 < 8; ++d0) gn[d0] = T.subln[d0 * 32 + r32];
        asm volatile("s_waitcnt lgkmcnt(0)" ::: "memory");
        DA_LAS float* Y = (DA_LAS float*)(lds + rb * 32768);
#pragma unroll
        for (int d0 = 0; d0 < 8; ++d0)
#pragma unroll
            for (int r = 0; r < 16; ++r) Y[crow(r, hi) * 256 + d0 * 32 + r32] = o[d0][r] * rs[r] * gn[d0];
        asm volatile("s_waitcnt lgkmcnt(0)" ::: "memory");
#pragma unroll 4
        for (int pass = 0; pass < 16; ++pass) { const int row = 2 * pass + hi;
            const DA_LAS f32x4* yp = (const DA_LAS f32x4*)(Y + row * 256 + r32 * 8); const f32x4 y0 = yp[0], y1 = yp[1];
            const size_t go = (size_t)(qw + row) * PITCH + h * 256 + r32 * 8;
            const u32x4 zz = *(const u32x4*)(T.Z + go);
            u32x4 w;
            w.x = cvtpk(y0[0] * silu(__uint_as_float(zz.x << 16)), y0[1] * silu(__uint_as_float(zz.x & 0xffff0000u)));
            w.y = cvtpk(y0[2] * silu(__uint_as_float(zz.y << 16)), y0[3] * silu(__uint_as_float(zz.y & 0xffff0000u)));
            w.z = cvtpk(y1[0] * silu(__uint_as_float(zz.z << 16)), y1[1] * silu(__uint_as_float(zz.z & 0xffff0000u)));
            w.w = cvtpk(y1[2] * silu(__uint_as_float(zz.w << 16)), y1[3] * silu(__uint_as_float(zz.w & 0xffff0000u)));
            *(u32x4*)(T.O + go) = w; }
    }
    DA_WAIT_BAR();
}

__device__ __forceinline__ void attn_phase(DA_LAS unsigned char* lds, const Tensors& T, const float* lamp, int vcu, int G) {
    const int lane = threadIdx.x & 63;
    float s1 = lamp[lane] * lamp[128 + lane] + lamp[64 + lane] * lamp[192 + lane];
    float s2 = lamp[256 + lane] * lamp[384 + lane] + lamp[320 + lane] * lamp[448 + lane];
#pragma unroll
    for (int o_ = 1; o_ < 64; o_ <<= 1) { s1 += __shfl_xor(s1, o_); s2 += __shfl_xor(s2, o_); }
    const float lam = __int_as_float(__builtin_amdgcn_readfirstlane(__float_as_int(expf(s1) - expf(s2) + 0.2f)));
    const int nit = (G == 256) ? 4 : (vcu < 1024 ? (1024 - vcu + G - 1) / G : 0);
    for (int u = 0; u < 2 * nit; ++u) {
        const int i = u >> 1; int h, pi;
        if (G == 256) { h = 2 * (vcu >> 5) + (i >> 1); pi = (i & 1) * 32 + (vcu & 31); }
        else { const int p = vcu + i * G; h = p >> 6; pi = p & 63; }
        attn_unit(h, (u & 1) ? pi : 127 - pi, T, lam, lds);
    }
}
#undef DA_WAIT_BAR
#undef DA_SBAR
}
#define GAS __attribute__((address_space(1)))
#define LAS __attribute__((address_space(3)))
typedef unsigned short bf16;
typedef unsigned v4u __attribute__((ext_vector_type(4)));
typedef float f32x4 __attribute__((ext_vector_type(4)));
typedef short bf16x8 __attribute__((ext_vector_type(8)));
typedef GAS unsigned gu32;
typedef GAS unsigned long long gu64;
#define RLX_AGENT __ATOMIC_RELAXED, __HIP_MEMORY_SCOPE_AGENT
#define LDS_WAIT() asm volatile("s_waitcnt lgkmcnt(0)" ::: "memory")
#define VM_WAIT() asm volatile("s_waitcnt vmcnt(0)" ::: "memory")
__device__ __forceinline__ unsigned long long rt() { return __builtin_amdgcn_s_memrealtime(); }
__device__ __forceinline__ unsigned f2bf(float f) { unsigned u = __builtin_bit_cast(unsigned, f); return (u + 0x7fffu + ((u >> 16) & 1u)) >> 16; }
__device__ __forceinline__ unsigned pk2(float lo, float hi) { return f2bf(lo) | (f2bf(hi) << 16); }

#define XB_TMO      128
#define XB_XCNT(j)  (256  + 64 * (j))
#define XB_XSUB(j)  (1280 + 64 * (j))
#define XB_XGEN(j)  (2304 + 64 * (j))
#define XB_TOP      3328
#define XB_TOPGEN   3392
#define XCD_BAR_WORDS 3456
#define XB_SPIN_CAP (1u << 18)

__device__ __forceinline__ unsigned xb_ld(unsigned* p)              { return __hip_atomic_load(p, __ATOMIC_RELAXED, __HIP_MEMORY_SCOPE_AGENT); }
__device__ __forceinline__ unsigned xb_add(unsigned* p, unsigned v) { return __hip_atomic_fetch_add(p, v, __ATOMIC_RELAXED, __HIP_MEMORY_SCOPE_AGENT); }
__device__ __forceinline__ unsigned xb_xcc_id() { return (unsigned)__builtin_amdgcn_s_getreg((3 << 11) | 20) & 0xFu; }
#define XB_SPIN(cond, bar) do { unsigned _sp = 0; while (cond) { __builtin_amdgcn_s_sleep(1); \
    if ((++_sp & 255u) == 0u) { if (xb_ld(&(bar)[XB_TMO])) break; if (_sp > XB_SPIN_CAP) { atomicAdd(&(bar)[XB_TMO], 1u); break; } } } } while (0)

struct XcdBarrier {
    unsigned* bar; unsigned x;
    volatile LAS unsigned* st;
};

__device__ __forceinline__ XcdBarrier xcd_barrier_post(unsigned* bar, volatile LAS unsigned* st) {
    XcdBarrier b; b.bar = bar; b.x = xb_xcc_id(); b.st = st;
    if (threadIdx.x == 0) (void)xb_add(&bar[XB_XCNT(b.x)], 1u);
    return b;
}
__device__ __forceinline__ void xcd_barrier_complete(unsigned* bar, unsigned x, unsigned& nloc, unsigned& nx) {
    const unsigned G = gridDim.x * gridDim.y * gridDim.z;
    unsigned sum, cnt, mine, sp = 0u;
    for (;;) {
        sum = 0u; cnt = 0u; mine = 0u;
#pragma unroll
        for (unsigned j = 0; j < 16; ++j) { const unsigned c = xb_ld(&bar[XB_XCNT(j)]); sum += c; cnt += (c > 0u) ? 1u : 0u; mine = (j == x) ? c : mine; }
        if (sum == G) break;
        __builtin_amdgcn_s_sleep(1);
        if ((++sp & 255u) == 0u) { if (xb_ld(&bar[XB_TMO])) break; if (sp > XB_SPIN_CAP) { atomicAdd(&bar[XB_TMO], 1u); break; } }
    }
    nloc = mine > 0u ? mine : 1u; nx = cnt > 0u ? cnt : 1u;
}

__device__ __forceinline__ void xcd_barrier(const XcdBarrier& b) {
    asm volatile("s_waitcnt vmcnt(0)" ::: "memory");
    __syncthreads();
    if (threadIdx.x == 0) {
        unsigned* bar = b.bar;
        __builtin_amdgcn_s_waitcnt(0);
        unsigned nloc = b.st[0], nx = b.st[1];
        if (nloc == 0u) { xcd_barrier_complete(bar, b.x, nloc, nx); b.st[0] = nloc; b.st[1] = nx; }
        const unsigned old = xb_add(&bar[XB_XSUB(b.x)], 1u);
        const unsigned gen = old / nloc;
        if (old + 1u == (gen + 1u) * nloc) {
            __builtin_amdgcn_fence(__ATOMIC_RELEASE, "agent");
            asm volatile("s_waitcnt vmcnt(0)" ::: "memory");
            const unsigned og = xb_add(&bar[XB_TOP], 1u);
            const unsigned tg = og / nx;
            if (og + 1u == (tg + 1u) * nx) xb_add(&bar[XB_TOPGEN], 1u);
            else XB_SPIN(xb_ld(&bar[XB_TOPGEN]) == tg, bar);
            __builtin_amdgcn_fence(__ATOMIC_ACQUIRE, "agent");
            xb_add(&bar[XB_XGEN(b.x)], 1u);
            asm volatile("s_waitcnt vmcnt(0)" ::: "memory");
        } else {
            XB_SPIN(xb_ld(&bar[XB_XGEN(b.x)]) == gen, bar);
            __builtin_amdgcn_fence(__ATOMIC_ACQUIRE, "agent");
            asm volatile("s_waitcnt vmcnt(0)" ::: "memory");
        }
    }
    __syncthreads();
}
constexpr int NWAVES = 8;
constexpr int SEQ = 16384, DM = 4096, NH = 16, AW = 4096, PW = 8192, PGD = 2048;
constexpr float NORM_EPS = 1e-6f;
#ifndef MK_N_LAUNCHES
#define MK_N_LAUNCHES 1
#endif
constexpr int N_PHASES = 9;

constexpr size_t MiB = 1u << 20;
constexpr size_t WS_CTL = 0, CTL_ZERO_BYTES = 256 * 1024;
constexpr size_t WS_SS1 = 64 * 1024, WS_SS2 = 128 * 1024;
constexpr size_t WS_SS0 = 256 * 1024;
constexpr size_t WS_WO1 = 2 * MiB, WS_WG = 34 * MiB, WS_WO2 = 66 * MiB, WS_W2 = 130 * MiB;
constexpr size_t WS_Q = 258 * MiB, WS_K = 386 * MiB, WS_V = 514 * MiB, WS_Z = 642 * MiB, WS_O = 770 * MiB;
constexpr size_t WS_P = 130 * MiB;
constexpr size_t WS_U = 386 * MiB, WS_Z2 = 642 * MiB;
constexpr size_t WS_END = 898 * MiB;
constexpr size_t OUT_W1 = 0, OUT_XB = 128 * MiB;
constexpr int CW_TMO = 0, CW_BAR = 4096;

constexpr int RING_BYTES = 131072;
constexpr int LDS_BYTES = 147456;
constexpr int MISC_OFF = LDS_BYTES - 256;
static_assert(dattn::LDS_END <= MISC_OFF && 8 * 64 * 65 * 4 <= MISC_OFF, "LDS map");

__device__ __forceinline__ float wave_sum(float v) {
#pragma unroll
    for (int o = 1; o < 64; o <<= 1) v += __shfl_xor(v, o);
    return v;
}
__device__ __forceinline__ void transpose_item(const float* W, int N, bf16* WT, int ldt, const float* gain, LAS float* scr, int item, int lane) {
    const int nblk = N >> 6, kb = item / nblk, nb = item - kb * nblk, k0 = kb * 64, n0 = nb * 64;
    const int lr = lane >> 4, lc = (lane & 15) * 4;
#pragma unroll 4
    for (int i = 0; i < 16; ++i) { const int kk = 4 * i + lr;
        f32x4 v = *(const f32x4*)(W + (size_t)(k0 + kk) * N + n0 + lc);
        if (gain) { const float g = gain[k0 + kk]; v = v * g; }
        LAS float* s = scr + kk * 65 + lc; s[0] = v[0]; s[1] = v[1]; s[2] = v[2]; s[3] = v[3]; }
    LDS_WAIT(); asm volatile("" ::: "memory");
    const int c = lane & 7;
#pragma unroll 2
    for (int j = 0; j < 8; ++j) { const int n = (lane >> 3) + 8 * j; const LAS float* s = scr + (8 * c) * 65 + n;
        v4u o; o.x = pk2(s[0 * 65], s[1 * 65]); o.y = pk2(s[2 * 65], s[3 * 65]); o.z = pk2(s[4 * 65], s[5 * 65]); o.w = pk2(s[6 * 65], s[7 * 65]);
        *(v4u*)(WT + (size_t)(n0 + n) * ldt + k0 + 8 * c) = o; }
    LDS_WAIT(); asm volatile("" ::: "memory");
}

struct Args { const float* in[12]; float* out; unsigned char* ws; int ph_lo, ph_hi; };

__global__ void __launch_bounds__(NWAVES * 64, 2) hybrid_fwd(Args args) {
    extern __shared__ __attribute__((aligned(16))) unsigned char lds_raw[];
    LAS unsigned char* lds = (LAS unsigned char*)lds_raw;
    volatile LAS unsigned* MISC = (volatile LAS unsigned*)(lds + MISC_OFF);
    const int tid = threadIdx.x, lane = tid & 63, wave = __builtin_amdgcn_readfirstlane(tid >> 6);
    const int G = gridDim.x; const int bx = blockIdx.x; const int vcu = (G % 8 == 0) ? (bx % 8) * (G / 8) + bx / 8 : bx;
    unsigned char* ws = args.ws; unsigned char* outb = (unsigned char*)args.out;
    const float* x = args.in[0]; const float* norm_gains = args.in[1]; const float* final_gain = args.in[2]; const float* rel_bias = args.in[3];
    const float* attn_w_in = args.in[4]; const float* attn_lambda = args.in[5]; const float* attn_subln = args.in[6]; const float* attn_w_out = args.in[7];
    const float* pool_w_in = args.in[8]; const float* pool_w_group = args.in[9]; const float* pool_scale = args.in[10]; const float* pool_w_out = args.in[11];
    unsigned* ctl = (unsigned*)(ws + WS_CTL);
    float* ss0 = (float*)(ws + WS_SS0); float* ss1 = (float*)(ws + WS_SS1); float* ss2 = (float*)(ws + WS_SS2);
    bf16* W1t = (bf16*)(outb + OUT_W1); bf16* XB = (bf16*)(outb + OUT_XB);
    bf16* Wo1t = (bf16*)(ws + WS_WO1); bf16* Wgt = (bf16*)(ws + WS_WG); bf16* Wo2t = (bf16*)(ws + WS_WO2); bf16* W2t = (bf16*)(ws + WS_W2);
    bf16* Qp = (bf16*)(ws + WS_Q); bf16* Kp = (bf16*)(ws + WS_K); bf16* Vp = (bf16*)(ws + WS_V); bf16* Zp = (bf16*)(ws + WS_Z); bf16* Op = (bf16*)(ws + WS_O);
    bf16* XB1 = Qp; bf16* Pp = (bf16*)(ws + WS_P); bf16* Up = (bf16*)(ws + WS_U); bf16* Z2p = (bf16*)(ws + WS_Z2); bf16* MZ = Up;
    float* xres = args.out;

    if (tid < 64) ((LAS unsigned*)(lds + MISC_OFF))[tid] = 0u;
    __syncthreads();
    XcdBarrier bar; bar.bar = ctl + CW_BAR; bar.x = 0; bar.st = nullptr;
    if (MK_N_LAUNCHES == 1) bar = xcd_barrier_post(ctl + CW_BAR, MISC);
    const int lo = args.ph_lo, hi = args.ph_hi;
#define IN(k) (lo <= (k) && (k) < hi)
#define GRID_BAR(k) do { if (IN((k) + 1)) xcd_barrier(bar); } while (0)

    if (IN(0)) {
        LAS float* scr = (LAS float*)lds + wave * (64 * 65);
        const int gw = vcu * NWAVES + wave, NGW = G * NWAVES;
        constexpr int I_W1 = (DM / 64) * (4 * AW / 64), I_WO1 = (AW / 64) * (DM / 64), I_W2 = (DM / 64) * (2 * PW / 64), I_WG = (PGD / 64) * (PGD / 64), I_WO2 = (PW / 64) * (DM / 64);
        constexpr int NITEMS = I_W1 + I_WO1 + I_W2 + 4 * I_WG + I_WO2;
        for (int it = gw; it < NITEMS; it += NGW) {
            int r = it;
            if (r < I_W1) { transpose_item(attn_w_in, 4 * AW, W1t, DM, norm_gains, scr, r, lane); continue; } r -= I_W1;
            if (r < I_WO1) { transpose_item(attn_w_out, DM, Wo1t, AW, nullptr, scr, r, lane); continue; } r -= I_WO1;
            if (r < I_W2) { transpose_item(pool_w_in, 2 * PW, W2t, DM, norm_gains + DM, scr, r, lane); continue; } r -= I_W2;
            if (r < 4 * I_WG) { const int g = r / I_WG; transpose_item(pool_w_group + (size_t)g * PGD * PGD, PGD, Wgt + (size_t)g * PGD * PGD, PGD, nullptr, scr, r - g * I_WG, lane); continue; } r -= 4 * I_WG;
            transpose_item(pool_w_out, DM, Wo2t, PW, nullptr, scr, r, lane);
        }
        for (int m = gw; m < SEQ; m += NGW) {
            const f32x4* xr = (const f32x4*)(x + (size_t)m * DM) + lane; unsigned long long* o8 = (unsigned long long*)(XB + (size_t)m * DM) + lane; float s = 0.f;
#pragma unroll 4
            for (int j = 0; j < 16; ++j) { const f32x4 v = xr[64 * j]; s += (v[0] * v[0] + v[1] * v[1]) + (v[2] * v[2] + v[3] * v[3]);
                o8[64 * j] = (unsigned long long)pk2(v[0], v[1]) | ((unsigned long long)pk2(v[2], v[3]) << 32); }
            s = wave_sum(s); if (lane == 0) ss0[m] = s;
        }
        GRID_BAR(0);
    }
    if (IN(1)) {
        pg8::Gemm g{XB, W1t, SEQ, 4 * AW, DM, DM, DM, -1, 0}; pg8::StaticOrder S; S.init(SEQ, 4 * AW, G, bx);
        pg8::EpiNormSplit E{Qp, ss0, AW, (size_t)(WS_K - WS_Q) / 2, dattn::QSCALE, NORM_EPS};
        pg8::gemm_phase<pg8::EpiNormSplit, pg8::StaticOrder, true, true>(lds, g, S, E);
        GRID_BAR(1);
    }
    if (IN(2)) {
        const dattn::Tensors T{Qp, Kp, Vp, Zp, Op, rel_bias, attn_subln};
        dattn::attn_phase(lds, T, attn_lambda, vcu, G);
        GRID_BAR(2);
    }
    if (IN(3)) {
        pg8::Gemm g{Op, Wo1t, SEQ, DM, AW, AW, AW, -1, 0}; pg8::StaticOrder S; S.init(SEQ, DM, G, bx);
        pg8::EpiResid E{x, xres, XB1, ss1, DM};
        pg8::gemm_phase<pg8::EpiResid, pg8::StaticOrder, true, true>(lds, g, S, E);
        GRID_BAR(3);
    }
    if (IN(4)) {
        pg8::Gemm g{XB1, W2t, SEQ, 2 * PW, DM, DM, DM, -1, 0}; pg8::StaticOrder S; S.init(SEQ, 2 * PW, G, bx);
        pg8::EpiNormSplit E{Up, ss1, PW, (size_t)(WS_Z2 - WS_U) / 2, 1.0f, NORM_EPS};
        pg8::gemm_phase<pg8::EpiNormSplit, pg8::StaticOrder, true, true>(lds, g, S, E);
        GRID_BAR(4);
    }
    if (IN(5)) {
        const int gt = vcu * (NWAVES * 64) + tid, NT_ = G * NWAVES * 64;
        for (int task = gt; task < (SEQ / 64) * (PW / 8); task += NT_) {
            const int rc = task >> 10, cc = task & 1023, w = 2 << (cc >> 8), t0 = rc * 64;
            const bf16* up = Up + (size_t)cc * 8; bf16* pp = Pp + (size_t)cc * 8;
            float s[8];
#pragma unroll
            for (int e = 0; e < 8; ++e) s[e] = 0.f;
            for (int r = t0 - w; r < t0; ++r) if (r >= 0) { const v4u q = *(const v4u*)(up + (size_t)r * PW);
                s[0] += __uint_as_float(q.x << 16); s[1] += __uint_as_float(q.x & 0xffff0000u); s[2] += __uint_as_float(q.y << 16); s[3] += __uint_as_float(q.y & 0xffff0000u);
                s[4] += __uint_as_float(q.z << 16); s[5] += __uint_as_float(q.z & 0xffff0000u); s[6] += __uint_as_float(q.w << 16); s[7] += __uint_as_float(q.w & 0xffff0000u); }
#pragma unroll 2
            for (int t = t0; t < t0 + 64; ++t) {
                const v4u q = *(const v4u*)(up + (size_t)t * PW);
                float u[8]; u[0] = __uint_as_float(q.x << 16); u[1] = __uint_as_float(q.x & 0xffff0000u); u[2] = __uint_as_float(q.y << 16); u[3] = __uint_as_float(q.y & 0xffff0000u);
                u[4] = __uint_as_float(q.z << 16); u[5] = __uint_as_float(q.z & 0xffff0000u); u[6] = __uint_as_float(q.w << 16); u[7] = __uint_as_float(q.w & 0xffff0000u);
#pragma unroll
                for (int e = 0; e < 8; ++e) s[e] += u[e];
                if (t - w >= 0) { const v4u o_ = *(const v4u*)(up + (size_t)(t - w) * PW);
                    s[0] -= __uint_as_float(o_.x << 16); s[1] -= __uint_as_float(o_.x & 0xffff0000u); s[2] -= __uint_as_float(o_.y << 16); s[3] -= __uint_as_float(o_.y & 0xffff0000u);
                    s[4] -= __uint_as_float(o_.z << 16); s[5] -= __uint_as_float(o_.z & 0xffff0000u); s[6] -= __uint_as_float(o_.w << 16); s[7] -= __uint_as_float(o_.w & 0xffff0000u); }
                const float ic = 1.0f / (float)((t + 1 < w) ? t + 1 : w);
                v4u o; o.x = pk2(s[0] * ic - u[0], s[1] * ic - u[1]); o.y = pk2(s[2] * ic - u[2], s[3] * ic - u[3]); o.z = pk2(s[4] * ic - u[4], s[5] * ic - u[5]); o.w = pk2(s[6] * ic - u[6], s[7] * ic - u[7]);
                *(v4u*)(pp + (size_t)t * PW) = o;
            }
        }
        GRID_BAR(5);
    }
    if (IN(6)) {
        pg8::Gemm g{Pp, Wgt, SEQ, PW, PGD, PW, PGD, 3, PGD * 2}; pg8::StaticOrder S; S.init(SEQ, PW, G, bx);
        pg8::EpiPoolMix E{MZ, Z2p, pool_scale, PW};
        pg8::gemm_phase<pg8::EpiPoolMix, pg8::StaticOrder, true, true>(lds, g, S, E);
        GRID_BAR(6);
    }
    if (IN(7)) {
        pg8::Gemm g{MZ, Wo2t, SEQ, DM, PW, PW, PW, -1, 0}; pg8::StaticOrder S; S.init(SEQ, DM, G, bx);
        pg8::EpiResid E{xres, xres, nullptr, ss2, DM};
        pg8::gemm_phase<pg8::EpiResid, pg8::StaticOrder, true, true>(lds, g, S, E);
        GRID_BAR(7);
    }
    if (IN(8)) {
        const int gt = vcu * (NWAVES * 64) + tid, NT_ = G * NWAVES * 64;
        const bool bad = (MK_N_LAUNCHES == 1) && (__hip_atomic_load(ctl + CW_BAR + XB_TMO, __ATOMIC_RELAXED, __HIP_MEMORY_SCOPE_AGENT) != 0u);
        const float qnan = __builtin_nanf("");
        for (int i = gt; i < SEQ * (DM / 4); i += NT_) { const int row = i >> 10, c4 = i & 1023;
            const float rs = 1.0f / sqrtf(ss2[row] * (1.0f / 4096.0f) + NORM_EPS);
            f32x4 v = ((const f32x4*)xres)[i]; const f32x4 gg = ((const f32x4*)final_gain)[c4];
            v = v * rs * gg; if (bad) v = (f32x4){qnan, qnan, qnan, qnan};
            ((f32x4*)xres)[i] = v; }
    }
#undef IN
#undef GRID_BAR
}

extern "C" void kernel_launch(void* const* d_in, const int* in_sizes, int n_in, void* d_out, int out_size, void* d_ws, size_t ws_size, hipStream_t stream) {
    static int grid = 0;
    if (grid == 0) {
        if (n_in != 12 || in_sizes[0] != SEQ * DM || out_size != SEQ * DM || ws_size < WS_END) {
            fprintf(stderr, "kernel_launch: built for 12 inputs, x/out of %d floats, >= %zu bytes of workspace; got n_in %d, in0 %d, out %d, ws %zu; nothing launched\n", SEQ * DM, (size_t)WS_END, n_in, n_in > 0 ? in_sizes[0] : -1, out_size, ws_size); grid = -1; return; }
        int dev = 0, cus = 0, per_cu = 0;
        if (hipGetDevice(&dev) != hipSuccess || hipDeviceGetAttribute(&cus, hipDeviceAttributeMultiprocessorCount, dev) != hipSuccess) { fprintf(stderr, "kernel_launch: device query failed\n"); grid = -1; return; }
        if (hipFuncSetAttribute((const void*)hybrid_fwd, hipFuncAttributeMaxDynamicSharedMemorySize, LDS_BYTES) != hipSuccess) { fprintf(stderr, "kernel_launch: hipFuncSetAttribute failed\n"); grid = -1; return; }
        if (hipOccupancyMaxActiveBlocksPerMultiprocessor(&per_cu, (const void*)hybrid_fwd, NWAVES * 64, LDS_BYTES) != hipSuccess || per_cu < 1)
            fprintf(stderr, "kernel_launch: note: occupancy query reports %d workgroups per CU\n", per_cu);
        (void)hipGetLastError();
        grid = cus;
    }
    if (grid < 0) return;
    if (hipMemsetAsync((char*)d_ws + WS_CTL, 0, CTL_ZERO_BYTES, stream) != hipSuccess) { fprintf(stderr, "kernel_launch: hipMemsetAsync failed\n"); return; }
    Args a{};
    for (int i = 0; i < 12; ++i) a.in[i] = (const float*)d_in[i];
    a.out = (float*)d_out; a.ws = (unsigned char*)d_ws;
    for (int li = 0; li < MK_N_LAUNCHES; ++li) {
        a.ph_lo = (MK_N_LAUNCHES == 1) ? 0 : li; a.ph_hi = (MK_N_LAUNCHES == 1) ? N_PHASES : li + 1;
        hipLaunchKernelGGL(hybrid_fwd, dim3(grid), dim3(NWAVES * 64), LDS_BYTES, stream, a);
        const hipError_t le = hipPeekAtLastError();
        if (le != hipSuccess) { fprintf(stderr, "kernel_launch: launch %d failed: %s\n", li, hipGetErrorName(le)); break; }
    }
}
```

```cpp
#include <hip/hip_runtime.h>
#include <cstdio>
#include <cstdint>
#include <cmath>
namespace pg8 {
#define PG8_LAS __attribute__((address_space(3)))
typedef unsigned short bf16_t;
typedef short bf16x8 __attribute__((ext_vector_type(8)));
typedef float f32x4 __attribute__((ext_vector_type(4)));
typedef unsigned u32x4 __attribute__((ext_vector_type(4)));
typedef unsigned u32x2 __attribute__((ext_vector_type(2)));
constexpr int BM = 256, BK = 64, HALF = 128, HTB = HALF * BK * 2  , STAGE_BYTES = 8 * HTB, NXCD = 8, WGM = 4;

__host__ __device__ __forceinline__ int lds_byte(int r, int c) { const int st = (r >> 4) * 2 + (c >> 5), rr = r & 15, cc = c & 31, ob = rr * 64 + cc * 2; return st * 1024 + (ob ^ (((ob >> 9) & 1) << 5)); }
__host__ __device__ __forceinline__ void stage_rc(int b, int& R, int& C) { const int st = b / 1024, sb = b % 1024, swz = sb ^ (((sb >> 9) & 1) << 5); R = (st >> 1) * 16 + swz / 64; C = (st & 1) * 32 + (swz % 64) / 2; }
__host__ __device__ __forceinline__ int perm32(int rho) { const int n = rho >> 4, i = rho & 15; return 8 * (i >> 2) + 4 * n + (i & 3); }

struct Unit { int pm, pn; };
struct Gemm { const bf16_t* A; const bf16_t* Bt; int M, N, K, lda, ldb, gshift, gstride, bshift, bstride;
    __device__ __forceinline__ size_t aoff(int pn) const { return gshift >= 0 ? (size_t)(pn >> gshift) * (size_t)gstride : (size_t)0; }
    __device__ __forceinline__ size_t boff(int pm) const { return bshift >= 0 ? (size_t)(pm >> bshift) * (size_t)bstride : (size_t)0; } };

struct StaticOrder {
    int nM, nN, nwg, G, c;
    __host__ __device__ void init(int M, int N, int G_, int c_) { nM = M / BM; nN = N / BM; nwg = nM * nN; G = G_; c = c_; }
    __host__ __device__ bool next(int i, Unit& u) const {
        const long L = (long)i * G + c; if (L >= nwg) return false;
        int wgid = (int)L; { const int q = nwg / NXCD, r = nwg % NXCD, xcd = wgid % NXCD, off = wgid / NXCD; wgid = (xcd < r ? xcd * (q + 1) : r * (q + 1) + (xcd - r) * q) + off; }
        const int nig = WGM * nN, gid = wgid / nig, fm = gid * WGM, gsz = (nM - fm) < WGM ? (nM - fm) : WGM;
        u.pm = fm + ((wgid % nig) % gsz); u.pn = (wgid % nig) / gsz; return true;
    }
    __device__ __forceinline__ void a_ready(const Unit&) const {}
    __device__ __forceinline__ void done(const Unit&) const {}
};

struct PanelOrder {
    int nN, nwg, G, c;
    __host__ __device__ void init(int M, int N, int G_, int c_) { nN = N / BM; nwg = (M / BM) * nN; G = G_; c = c_; }
    __host__ __device__ bool next(int i, Unit& u) const {
        const long L0 = (long)i * G; if (L0 + c >= nwg) return false;
        if (nN % 16 == 0 && G % 64 == 0 && nwg % G == 0 && ((nwg / nN) % (G / 16)) == 0) {
            const int ncs = nN / 16, rg = i / ncs, sc = i - rg * ncs;
            const int q = c >> 6, h = (c >> 5) & 1, j = c & 31;
            u.pm = rg * (G / 16) + q * 4 + (j & 3); u.pn = sc * 16 + h * 8 + (j >> 2); return true; }
        const long L = L0 + c; u.pm = (int)(L / nN); u.pn = (int)(L % nN); return true;
    }
    __device__ __forceinline__ void a_ready(const Unit&) const {}
    __device__ __forceinline__ void done(const Unit&) const {}
};

__device__ __forceinline__ unsigned cvt_pk_bf16(float lo, float hi) { unsigned r; asm volatile("v_cvt_pk_bf16_f32 %0, %1, %2" : "=v"(r) : "v"(lo), "v"(hi)); return r; }
typedef float f32x2 __attribute__((ext_vector_type(2)));
template <class Epi, class Sched, bool ALIGN_EPI = false, bool SP2 = false>
__device__ __forceinline__ void gemm_phase(PG8_LAS unsigned char* lds, const Gemm g, const Sched& S, const Epi& E, const int wid) {
    int lane; asm volatile("v_mbcnt_lo_u32_b32 %0, -1, 0\n\tv_mbcnt_hi_u32_b32 %0, -1, %0" : "=v"(lane));
    const int tid = wid * 64 + lane, wr = wid >> 2, wc = wid & 3, fr = lane & 15, fq = lane >> 4;
    const int K = g.K, nt = K / BK;
    unsigned voffA[2], voffB[2];
#pragma unroll
    for (int i = 0; i < 2; ++i) { int R, C; stage_rc(tid * 16 + i * 8192, R, C); const int Rb = Epi::PERM ? ((R & ~31) + perm32(R & 31)) : R;
        voffA[i] = (unsigned)(R * g.lda + C) * 2u; voffB[i] = (unsigned)(Rb * g.ldb + C) * 2u; }
    const size_t kstep = (size_t)(BK * 2);
    const size_t hstepA = (size_t)HALF * g.lda * 2, hstepB = (size_t)HALF * g.ldb * 2;
    const size_t tstepA = 2 * hstepA, tstepB = 2 * hstepB;
    const unsigned ldsw = (unsigned)wid * 1024u;
    const int aoff = lds_byte(wr * 64 + fr, fq * 8), boff = lds_byte(wc * 32 + fr, fq * 8);
#define PG8_SA(b, h) (((b) * 2 + (h)) * HTB)
#define PG8_SB(b, h) ((4 + (b) * 2 + (h)) * HTB)
#define PG8_STAGE(bufoff, gbase, voff) do { _Pragma("unroll") for (int _i = 0; _i < 2; ++_i) \
        __builtin_amdgcn_global_load_lds((const unsigned*)((const char*)(gbase) + (voff)[_i]), (PG8_LAS unsigned*)(lds + (bufoff) + ldsw + _i * 8192), 16, 0, 0); } while (0)
#define PG8_LDA(dst, b, h) do { _Pragma("unroll") for (int m = 0; m < 4; ++m) _Pragma("unroll") for (int k = 0; k < 2; ++k) dst[m][k] = *(const PG8_LAS bf16x8*)(lds + PG8_SA(b, h) + aoff + m * 2048 + k * 1024); } while (0)
#define PG8_LDB(dst, b, h) do { _Pragma("unroll") for (int n = 0; n < 2; ++n) _Pragma("unroll") for (int k = 0; k < 2; ++k) dst[n][k] = *(const PG8_LAS bf16x8*)(lds + PG8_SB(b, h) + boff + n * 2048 + k * 1024); } while (0)
#define PG8_MMA(ai, bj, At, Bt) do { __builtin_amdgcn_s_setprio(1); _Pragma("unroll") for (int m = 0; m < 4; ++m) _Pragma("unroll") for (int n = 0; n < 2; ++n) _Pragma("unroll") for (int k = 0; k < 2; ++k) \
        acc[ai][bj][m][n] = (Epi::YNT && (bj) == 0) ? __builtin_amdgcn_mfma_f32_16x16x32_bf16(At[m][k], Bt[n][k], acc[ai][bj][m][n], 0, 0, 0) : __builtin_amdgcn_mfma_f32_16x16x32_bf16(Bt[n][k], At[m][k], acc[ai][bj][m][n], 0, 0, 0); __builtin_amdgcn_s_setprio(0); } while (0)
#define PG8_WAIT_V(n) asm volatile("s_waitcnt vmcnt(" #n ")" ::: "memory")
#define PG8_WAIT_L(n) asm volatile("s_waitcnt lgkmcnt(" #n ")" ::: "memory")
#define PG8_BAR __builtin_amdgcn_s_barrier()
#define PG8_SCHED __builtin_amdgcn_sched_barrier(0)
    Unit cur, nxt; int ui = 0;
    if (!S.next(0, cur)) return;
    f32x4 acc[2][2][4][2];
#pragma unroll
    for (int a = 0; a < 2; ++a)
#pragma unroll
        for (int b = 0; b < 2; ++b)
#pragma unroll
            for (int m = 0; m < 4; ++m)
#pragma unroll
                for (int n = 0; n < 2; ++n) acc[a][b][m][n] = (f32x4){0.f, 0.f, 0.f, 0.f};
    bf16x8 At[4][2], B0[2][2], B1[2][2];
    const char* cA = (const char*)g.A + (size_t)cur.pm * tstepA + g.aoff(cur.pn); const char* cB = (const char*)g.Bt + (size_t)cur.pn * tstepB + g.boff(cur.pm);
    S.a_ready(cur);
    if constexpr (SP2) {
        PG8_STAGE(PG8_SB(0, 0), cB, voffB); PG8_STAGE(PG8_SB(0, 1), cB + hstepB, voffB); PG8_STAGE(PG8_SA(0, 0), cA, voffA); PG8_STAGE(PG8_SA(0, 1), cA + hstepA, voffA);
        if (wr == 1) PG8_BAR;
        PG8_WAIT_V(2); PG8_BAR;
        PG8_STAGE(PG8_SB(1, 0), cB + kstep, voffB); PG8_STAGE(PG8_SA(1, 0), cA + kstep, voffA); PG8_STAGE(PG8_SB(1, 1), cB + hstepB + kstep, voffB);
        PG8_WAIT_V(6); PG8_BAR;
    } else {
        PG8_STAGE(PG8_SB(0, 0), cB, voffB); PG8_STAGE(PG8_SA(0, 0), cA, voffA); PG8_STAGE(PG8_SB(0, 1), cB + hstepB, voffB); PG8_STAGE(PG8_SA(0, 1), cA + hstepA, voffA);
        if (wr == 1) PG8_BAR;
        PG8_WAIT_V(4); PG8_BAR;
        PG8_STAGE(PG8_SB(1, 0), cB + kstep, voffB); PG8_STAGE(PG8_SA(1, 0), cA + kstep, voffA); PG8_STAGE(PG8_SB(1, 1), cB + hstepB + kstep, voffB);
        PG8_WAIT_V(6); PG8_BAR;
    }
    for (;;) {
        const bool has_next = S.next(ui + 1, nxt);
        const char* nA = has_next ? (const char*)g.A + (size_t)nxt.pm * tstepA + g.aoff(nxt.pn) : cA; const char* nB = has_next ? (const char*)g.Bt + (size_t)nxt.pn * tstepB + g.boff(nxt.pm) : cB;
        for (int t = 0; t < nt; t += 2) {
            const bool last = (t == nt - 2);
            const char* a1 = cA + (size_t)(t + 1) * kstep;
            const char* a2 = last ? nA : cA + (size_t)(t + 2) * kstep; const char* b2 = last ? nB : cB + (size_t)(t + 2) * kstep;
            const char* a3 = a2 + kstep; const char* b3 = b2 + kstep;
            if (last && has_next) S.a_ready(nxt);
            if constexpr (SP2) {
            PG8_LDB(B0, 0, 0); PG8_LDB(B1, 0, 1); PG8_SCHED; PG8_LDA(At, 0, 0); PG8_STAGE(PG8_SA(1, 1), a1 + hstepA, voffA);
            PG8_WAIT_V(8); PG8_WAIT_L(0); PG8_BAR; PG8_MMA(0, 0, At, B0); PG8_MMA(0, 1, At, B1); PG8_BAR; PG8_SCHED;
            PG8_LDA(At, 0, 1); PG8_STAGE(PG8_SB(0, 0), b2, voffB); PG8_STAGE(PG8_SB(0, 1), b2 + hstepB, voffB); PG8_STAGE(PG8_SA(0, 0), a2, voffA);
            PG8_WAIT_V(8); PG8_WAIT_L(0); PG8_BAR; PG8_MMA(1, 0, At, B0); PG8_MMA(1, 1, At, B1); PG8_BAR; PG8_SCHED;
            PG8_LDB(B0, 1, 0); PG8_LDB(B1, 1, 1); PG8_SCHED; PG8_LDA(At, 1, 0); PG8_STAGE(PG8_SA(0, 1), a2 + hstepA, voffA);
            PG8_WAIT_V(8); PG8_WAIT_L(0); PG8_BAR; PG8_MMA(0, 0, At, B0); PG8_MMA(0, 1, At, B1); PG8_BAR; PG8_SCHED;
            PG8_LDA(At, 1, 1); PG8_STAGE(PG8_SB(1, 0), b3, voffB); PG8_STAGE(PG8_SB(1, 1), b3 + hstepB, voffB); PG8_STAGE(PG8_SA(1, 0), a3, voffA);
            PG8_WAIT_V(8); PG8_WAIT_L(0); PG8_BAR; PG8_MMA(1, 0, At, B0); PG8_MMA(1, 1, At, B1); PG8_BAR; PG8_SCHED;
            } else {
            PG8_LDB(B0, 0, 0); PG8_SCHED; PG8_LDA(At, 0, 0); PG8_STAGE(PG8_SA(1, 1), a1 + hstepA, voffA);
            PG8_WAIT_L(8); PG8_BAR; PG8_WAIT_L(0); PG8_MMA(0, 0, At, B0); PG8_BAR; PG8_SCHED;
            PG8_LDB(B1, 0, 1); PG8_STAGE(PG8_SB(0, 0), b2, voffB);
            PG8_BAR; PG8_WAIT_L(0); PG8_MMA(0, 1, At, B1); PG8_BAR;
            PG8_LDA(At, 0, 1); PG8_STAGE(PG8_SA(0, 0), a2, voffA);
            PG8_BAR; PG8_WAIT_L(0); PG8_MMA(1, 0, At, B0); PG8_BAR; PG8_SCHED;
            PG8_STAGE(PG8_SB(0, 1), b2 + hstepB, voffB);
            PG8_WAIT_V(6); PG8_BAR; PG8_MMA(1, 1, At, B1); PG8_BAR;
            PG8_LDB(B0, 1, 0); PG8_SCHED; PG8_LDA(At, 1, 0); PG8_STAGE(PG8_SA(0, 1), a2 + hstepA, voffA);
            PG8_WAIT_L(8); PG8_BAR; PG8_WAIT_L(0); PG8_MMA(0, 0, At, B0); PG8_BAR; PG8_SCHED;
            PG8_LDB(B1, 1, 1); PG8_STAGE(PG8_SB(1, 0), b3, voffB);
            PG8_BAR; PG8_WAIT_L(0); PG8_MMA(0, 1, At, B1); PG8_BAR;
            PG8_LDA(At, 1, 1); PG8_STAGE(PG8_SA(1, 0), a3, voffA);
            PG8_BAR; PG8_WAIT_L(0); PG8_MMA(1, 0, At, B0); PG8_BAR; PG8_SCHED;
            PG8_STAGE(PG8_SB(1, 1), b3 + hstepB, voffB);
            PG8_WAIT_V(6); PG8_BAR; PG8_MMA(1, 1, At, B1); PG8_BAR;
            }
        }
        if constexpr (ALIGN_EPI) { if (wr == 0) PG8_BAR; }
        if constexpr (!Epi::AFTER_DRAIN) { E(acc, cur, wr, wc, fr, fq); S.done(cur); }
        if (!has_next) break;
#pragma unroll
        for (int a = 0; a < 2; ++a)
#pragma unroll
            for (int b = 0; b < 2; ++b)
#pragma unroll
                for (int m = 0; m < 4; ++m)
#pragma unroll
                    for (int n = 0; n < 2; ++n) acc[a][b][m][n] = (f32x4){0.f, 0.f, 0.f, 0.f};
        cur = nxt; cA = nA; cB = nB; ++ui;
        if constexpr (ALIGN_EPI) { if (wr == 1) PG8_BAR; }
    }
    PG8_WAIT_V(0);
    if constexpr (!ALIGN_EPI) { if (wr == 0) PG8_BAR; }
    PG8_BAR;
    if constexpr (Epi::AFTER_DRAIN) { E.fused(acc, cur, wr, wc, fr, fq, lds, wid, lane); S.done(cur); }
#undef PG8_SA
#undef PG8_SB
#undef PG8_STAGE
#undef PG8_LDA
#undef PG8_LDB
#undef PG8_MMA
#undef PG8_WAIT_V
#undef PG8_WAIT_L
#undef PG8_BAR
#undef PG8_SCHED
}
}
namespace pg8 {
__device__ __forceinline__ u32x4 pack8_bf16(const f32x4 v0, const f32x4 v1) { u32x4 w; w.x = cvt_pk_bf16(v0[0], v0[1]); w.y = cvt_pk_bf16(v0[2], v0[3]); w.z = cvt_pk_bf16(v1[0], v1[1]); w.w = cvt_pk_bf16(v1[2], v1[3]); return w; }

struct EpiNormSplit {
    static constexpr bool PERM = true, AFTER_DRAIN = false, YNT = false;
    bf16_t* O; const float* ss; int split_cols; size_t split_stride; float scale0; float eps; int zplane; float scalez;
    __device__ __forceinline__ void operator()(const f32x4 (&acc)[2][2][4][2], const Unit& u, int wr, int wc, int fr, int fq) const {
        const int row0 = u.pm * BM + wr * 64 + fr; int colt = u.pn * BM; bf16_t* base = O;
        const int t = colt / split_cols; base += (size_t)t * split_stride; colt -= t * split_cols;
        const float sc = (t == 0) ? scale0 : ((t == zplane) ? scalez : 1.f);
        const int col0 = colt + wc * 32 + 8 * fq;
#pragma unroll
        for (int ai = 0; ai < 2; ++ai)
#pragma unroll
            for (int m = 0; m < 4; ++m) { const int row = row0 + ai * HALF + m * 16;
                const float rs = sc / sqrtf(ss[row] * (1.0f / 4096.0f) + eps);
                bf16_t* rowp = base + (size_t)row * split_cols + col0;
#pragma unroll
                for (int bj = 0; bj < 2; ++bj) { const f32x4 v0 = acc[ai][bj][m][0] * rs, v1 = acc[ai][bj][m][1] * rs; *(u32x4*)(rowp + bj * HALF) = pack8_bf16(v0, v1); } }
    }
};

struct EpiPlain {
    static constexpr bool PERM = true, AFTER_DRAIN = false, YNT = false;
    bf16_t* O; int ldc; int ymap;
    __device__ __forceinline__ void operator()(const f32x4 (&acc)[2][2][4][2], const Unit& u, int wr, int wc, int fr, int fq) const {
        const int row0 = u.pm * BM + wr * 64 + fr, col0 = u.pn * BM + wc * 32 + 8 * fq;
#pragma unroll
        for (int ai = 0; ai < 2; ++ai)
#pragma unroll
            for (int m = 0; m < 4; ++m) { int row = row0 + ai * HALF + m * 16; if (ymap) row = ((row >> 7) << 8) + (row & 127);
                bf16_t* rowp = O + (size_t)row * ldc + col0;
#pragma unroll
                for (int bj = 0; bj < 2; ++bj) *(u32x4*)(rowp + bj * HALF) = pack8_bf16(acc[ai][bj][m][0], acc[ai][bj][m][1]); }
    }
};

struct EpiResid {
    static constexpr bool PERM = true, AFTER_DRAIN = false, YNT = false;
    const float* base; const bf16_t* baseh; float* out; bf16_t* xb; float* ss; int ldc;
    __device__ __forceinline__ void operator()(const f32x4 (&acc)[2][2][4][2], const Unit& u, int wr, int wc, int fr, int fq) const {
        const int row0 = u.pm * BM + wr * 64 + fr, col0 = u.pn * BM + wc * 32 + 8 * fq;
#pragma unroll
        for (int ai = 0; ai < 2; ++ai)
#pragma unroll
            for (int m = 0; m < 4; ++m) { const int row = row0 + ai * HALF + m * 16; const size_t off = (size_t)row * ldc + col0; float sq = 0.f;
#pragma unroll
                for (int bj = 0; bj < 2; ++bj) { f32x4 b0, b1;
                    if (base) { const float* bp = base + off + bj * HALF; b0 = *(const f32x4*)bp; b1 = *(const f32x4*)(bp + 4); }
                    else { const u32x4 hq = *(const u32x4*)(baseh + off + bj * HALF);
                        b0[0] = __uint_as_float(hq.x << 16); b0[1] = __uint_as_float(hq.x & 0xffff0000u); b0[2] = __uint_as_float(hq.y << 16); b0[3] = __uint_as_float(hq.y & 0xffff0000u);
                        b1[0] = __uint_as_float(hq.z << 16); b1[1] = __uint_as_float(hq.z & 0xffff0000u); b1[2] = __uint_as_float(hq.w << 16); b1[3] = __uint_as_float(hq.w & 0xffff0000u); }
                    const f32x4 v0 = acc[ai][bj][m][0] + b0, v1 = acc[ai][bj][m][1] + b1;
                    if (out) { *(f32x4*)(out + off + bj * HALF) = v0; *(f32x4*)(out + off + bj * HALF + 4) = v1; }
                    sq += (v0[0] * v0[0] + v0[1] * v0[1]) + (v0[2] * v0[2] + v0[3] * v0[3]) + (v1[0] * v1[0] + v1[1] * v1[1]) + (v1[2] * v1[2] + v1[3] * v1[3]);
                    if (xb) *(u32x4*)(xb + off + bj * HALF) = pack8_bf16(v0, v1); }
                sq += __shfl_xor(sq, 16); sq += __shfl_xor(sq, 32);
                if (fq == 0) unsafeAtomicAdd(ss + row, sq); }
    }
};

struct EpiPool {
    static constexpr bool PERM = true, AFTER_DRAIN = false, YNT = true;
    bf16_t* MZ; bf16_t* Yf; bf16_t* Yl; const float* ss; const float* pscale; PG8_LAS unsigned char* xl; float eps;
    __device__ __forceinline__ void operator()(const f32x4 (&acc)[2][2][4][2], const Unit& u, int wr, int wc, int fr, int fq) const {
        constexpr int LDC = 8192;
        const int wid = wr * 4 + wc, lane = fq * 16 + fr;
        const int w = 2 << (u.pn >> 4);
        const int rowb = u.pm * BM + wr * 64, colb = u.pn * HALF + wc * 32 + 8 * fq;
        PG8_LAS float* RS = (PG8_LAS float*)xl + wid * 128;
        PG8_LAS u32x2* HALO = (PG8_LAS u32x2*)(xl + 4096);
        float rst[2][4];
#pragma unroll
        for (int ai = 0; ai < 2; ++ai)
#pragma unroll
            for (int m = 0; m < 4; ++m) { rst[ai][m] = 1.0f / sqrtf(ss[rowb + ai * HALF + m * 16 + fr] * (1.0f / 4096.0f) + eps); if (fq == 0) RS[(ai * 4 + m) * 16 + fr] = rst[ai][m]; }
        asm volatile("s_waitcnt lgkmcnt(0)" ::: "memory");
        u32x2 ypk[2][4][2];
#pragma unroll
        for (int ai = 0; ai < 2; ++ai)
#pragma unroll
            for (int m = 0; m < 4; ++m) { const f32x4 rn = *(const PG8_LAS f32x4*)(RS + (ai * 4 + m) * 16 + 4 * fq);
#pragma unroll
                for (int n = 0; n < 2; ++n) { const f32x4 v = acc[ai][0][m][n] * rn; ypk[ai][m][n].x = cvt_pk_bf16(v[0], v[1]); ypk[ai][m][n].y = cvt_pk_bf16(v[2], v[3]); } }
#pragma unroll
        for (int n = 0; n < 2; ++n) {
            if (wr == 0) { HALO[((0 * 4 + wc) * 2 + n) * 64 + lane] = ypk[0][3][n]; HALO[((2 * 4 + wc) * 2 + n) * 64 + lane] = ypk[1][3][n]; }
            else HALO[((1 * 4 + wc) * 2 + n) * 64 + lane] = ypk[0][3][n]; }
        asm volatile("s_waitcnt lgkmcnt(0)" ::: "memory");
        __syncthreads();
        u32x2 hal[2][2];
#pragma unroll
        for (int n = 0; n < 2; ++n) {
            hal[0][n] = (u32x2){0u, 0u}; if (wr == 1) hal[0][n] = HALO[((0 * 4 + wc) * 2 + n) * 64 + lane];
            hal[1][n] = HALO[(((wr == 0 ? 1 : 2) * 4 + wc) * 2 + n) * 64 + lane]; }
        const float invw = 1.0f / (float)w;
        float cp[4], cc[4], ci[4];
#pragma unroll
        for (int e = 0; e < 4; ++e) { const int p = 4 * fq + e, dp = fr + 16 - p, dc = fr - p;
            cp[e] = (dp < w) ? invw : 0.f; cc[e] = (dc == 0) ? invw - 1.0f : ((dc > 0 && dc < w) ? invw : 0.f); ci[e] = (dc == 0) ? 1.0f : 0.f; }
        u32x4 bpw, biw; bpw.x = cvt_pk_bf16(cp[0], cp[1]); bpw.y = cvt_pk_bf16(cp[2], cp[3]); bpw.z = cvt_pk_bf16(cc[0], cc[1]); bpw.w = cvt_pk_bf16(cc[2], cc[3]);
        biw.x = 0u; biw.y = 0u; biw.z = cvt_pk_bf16(ci[0], ci[1]); biw.w = cvt_pk_bf16(ci[2], ci[3]);
        const bf16x8 bp = __builtin_bit_cast(bf16x8, bpw), bi = __builtin_bit_cast(bf16x8, biw);
        const f32x4 ps0 = *(const f32x4*)(pscale + colb) * 0.6931471805599453f, ps1 = *(const f32x4*)(pscale + colb + 4) * 0.6931471805599453f;
        const f32x4 zero4 = (f32x4){0.f, 0.f, 0.f, 0.f};
        float zf; asm volatile("v_mov_b32 %0, 0" : "=v"(zf));
#pragma unroll
        for (int ai = 0; ai < 2; ++ai)
#pragma unroll
            for (int m = 0; m < 4; ++m) {
                const int row = rowb + ai * HALF + m * 16 + fr; bf16_t* dst = MZ + (size_t)row * LDC + colb;
                const float zs = rst[ai][m] * 1.4426950408889634f;
                f32x4 z0 = acc[ai][1][m][0] * zs, z1 = acc[ai][1][m][1] * zs;
                const bool first = (ai == 0 && m == 0) && (wr == 0), lastb = (ai == 1 && m == 3) && (wr == 1);
                if (first || lastb) {
                    u32x4 a0, a1; a0.x = 0u; a0.y = 0u; a0.z = ypk[ai][m][0].x; a0.w = ypk[ai][m][0].y; a1.x = 0u; a1.y = 0u; a1.z = ypk[ai][m][1].x; a1.w = ypk[ai][m][1].y;
                    const f32x4 y0 = __builtin_amdgcn_mfma_f32_16x16x32_bf16(__builtin_bit_cast(bf16x8, a0), bi, zero4, 0, 0, 0), y1 = __builtin_amdgcn_mfma_f32_16x16x32_bf16(__builtin_bit_cast(bf16x8, a1), bi, zero4, 0, 0, 0);
                    bf16_t* yd = (first ? Yf : Yl) + ((size_t)u.pm * 16 + fr) * LDC + colb;
                    *(u32x4*)yd = pack8_bf16(y0 + zf, y1 + zf); }
                if (first) { *(u32x4*)dst = pack8_bf16(z0, z1); }
                else {
                    const u32x2 pv0 = (m > 0) ? ypk[ai][m > 0 ? m - 1 : 0][0] : hal[ai][0], pv1 = (m > 0) ? ypk[ai][m > 0 ? m - 1 : 0][1] : hal[ai][1];
                    u32x4 a0, a1; a0.x = pv0.x; a0.y = pv0.y; a0.z = ypk[ai][m][0].x; a0.w = ypk[ai][m][0].y; a1.x = pv1.x; a1.y = pv1.y; a1.z = ypk[ai][m][1].x; a1.w = ypk[ai][m][1].y;
                    f32x4 d0 = __builtin_amdgcn_mfma_f32_16x16x32_bf16(__builtin_bit_cast(bf16x8, a0), bp, zero4, 0, 0, 0), d1 = __builtin_amdgcn_mfma_f32_16x16x32_bf16(__builtin_bit_cast(bf16x8, a1), bp, zero4, 0, 0, 0);
#pragma unroll
                    for (int e = 0; e < 4; ++e) { d0[e] *= ps0[e] * (z0[e] * __builtin_amdgcn_rcpf(1.0f + __builtin_amdgcn_exp2f(-z0[e]))); d1[e] *= ps1[e] * (z1[e] * __builtin_amdgcn_rcpf(1.0f + __builtin_amdgcn_exp2f(-z1[e]))); }
                    *(u32x4*)dst = pack8_bf16(d0, d1); }
            }
    }
};

struct EpiFinal {
    static constexpr bool PERM = true, AFTER_DRAIN = false, YNT = false;
    const bf16_t* baseh; float* out; float* ss; unsigned* cnt; unsigned* tmo; const float* gain; int ldc; float eps; unsigned nown;
    __device__ __forceinline__ void base8(const size_t off, f32x4& b0, f32x4& b1) const { const u32x4 hq = *(const u32x4*)(baseh + off);
        b0[0] = __uint_as_float(hq.x << 16); b0[1] = __uint_as_float(hq.x & 0xffff0000u); b0[2] = __uint_as_float(hq.y << 16); b0[3] = __uint_as_float(hq.y & 0xffff0000u);
        b1[0] = __uint_as_float(hq.z << 16); b1[1] = __uint_as_float(hq.z & 0xffff0000u); b1[2] = __uint_as_float(hq.w << 16); b1[3] = __uint_as_float(hq.w & 0xffff0000u); }
    __device__ __forceinline__ void operator()(const f32x4 (&acc)[2][2][4][2], const Unit& u, int wr, int wc, int fr, int fq) const {
        const int row0 = u.pm * BM + wr * 64 + fr, col0 = u.pn * BM + wc * 32 + 8 * fq;
#pragma unroll
        for (int ai = 0; ai < 2; ++ai)
#pragma unroll
            for (int m = 0; m < 4; ++m) { const int row = row0 + ai * HALF + m * 16; const size_t off = (size_t)row * ldc + col0; float sq = 0.f;
#pragma unroll
                for (int bj = 0; bj < 2; ++bj) { f32x4 b0, b1; base8(off + bj * HALF, b0, b1);
                    const f32x4 v0 = acc[ai][bj][m][0] + b0, v1 = acc[ai][bj][m][1] + b1;
                    sq += (v0[0] * v0[0] + v0[1] * v0[1]) + (v0[2] * v0[2] + v0[3] * v0[3]) + (v1[0] * v1[0] + v1[1] * v1[1]) + (v1[2] * v1[2] + v1[3] * v1[3]); }
                sq += __shfl_xor(sq, 16); sq += __shfl_xor(sq, 32);
                if (fq == 0) unsafeAtomicAdd(ss + row, sq); }
        asm volatile("s_waitcnt vmcnt(0)" ::: "memory");
        __syncthreads();
        if (wr == 0 && wc == 0 && fr == 0 && fq == 0) {
            unsigned* c = cnt + u.pm;
            (void)__hip_atomic_fetch_add(c, 1u, __ATOMIC_RELAXED, __HIP_MEMORY_SCOPE_AGENT);
            unsigned sp = 0u;
            while (__hip_atomic_load(c, __ATOMIC_RELAXED, __HIP_MEMORY_SCOPE_AGENT) < nown) { __builtin_amdgcn_s_sleep(1);
                if ((++sp & 255u) == 0u) { if (__hip_atomic_load(tmo, __ATOMIC_RELAXED, __HIP_MEMORY_SCOPE_AGENT)) break; if (sp > (1u << 18)) { atomicAdd(tmo, 1u); break; } } }
        }
        __syncthreads();
        const bool bad = __hip_atomic_load(tmo, __ATOMIC_RELAXED, __HIP_MEMORY_SCOPE_AGENT) != 0u;
        const float qnan = __builtin_nanf("");
        f32x4 gg[2][2];
#pragma unroll
        for (int bj = 0; bj < 2; ++bj)
#pragma unroll
            for (int n = 0; n < 2; ++n) gg[bj][n] = *(const f32x4*)(gain + col0 + bj * HALF + 4 * n);
#pragma unroll
        for (int ai = 0; ai < 2; ++ai)
#pragma unroll
            for (int m = 0; m < 4; ++m) { const int row = row0 + ai * HALF + m * 16; const size_t off = (size_t)row * ldc + col0;
                const float ssv = __hip_atomic_load(ss + row, __ATOMIC_RELAXED, __HIP_MEMORY_SCOPE_AGENT);
                const float rs = bad ? qnan : 1.0f / sqrtf(ssv * (1.0f / 4096.0f) + eps);
#pragma unroll
                for (int bj = 0; bj < 2; ++bj) { f32x4 b0, b1; base8(off + bj * HALF, b0, b1);
                    const f32x4 v0 = (acc[ai][bj][m][0] + b0) * rs * gg[bj][0], v1 = (acc[ai][bj][m][1] + b1) * rs * gg[bj][1];
                    __builtin_nontemporal_store(v0, (f32x4*)(out + off + bj * HALF)); __builtin_nontemporal_store(v1, (f32x4*)(out + off + bj * HALF + 4)); } }
    }
};

}
namespace dattn {
#define DA_LAS __attribute__((address_space(3)))
typedef unsigned short bf16_t;
typedef short bf16x8 __attribute__((ext_vector_type(8)));
typedef short s16x4 __attribute__((ext_vector_type(4)));
typedef float f32x16 __attribute__((ext_vector_type(16)));
typedef float f32x4 __attribute__((ext_vector_type(4)));
typedef unsigned u32x4 __attribute__((ext_vector_type(4)));
constexpr int PITCH = 4096;
constexpr int STAGE = 65536, OFF_V = 32768;
constexpr int OFF_TBL = 131072, OFF_WS = OFF_TBL + 512, LDS_END = OFF_WS + 8 * 256;
constexpr float LOG2E = 1.4426950408889634f;
constexpr float THR = 8.0f;
constexpr float QSCALE = 0.08838834764831845f * LOG2E;

__device__ __forceinline__ int crow(int r, int hi) { return (r & 3) + 8 * (r >> 2) + 4 * hi; }
__device__ __forceinline__ unsigned cvtpk(float lo, float hi) { unsigned r; asm volatile("v_cvt_pk_bf16_f32 %0, %1, %2" : "=v"(r) : "v"(lo), "v"(hi)); return r; }
__device__ __forceinline__ int v_rd_base(int lane) { return ((lane & 3) << 3) | (((lane >> 2) & 3) << 6) | (((lane >> 4) & 1) << 5) | (((lane >> 5) & 1) << 8); }
__device__ __forceinline__ float silu(float z) { return z * __builtin_amdgcn_rcpf(1.0f + __builtin_amdgcn_exp2f(-LOG2E * z)); }

__device__ __forceinline__ int fresh_lane() { int l; asm volatile("v_mbcnt_lo_u32_b32 %0, -1, 0\n\tv_mbcnt_hi_u32_b32 %0, -1, %0" : "=v"(l)); return l; }
template <int M> __device__ __forceinline__ float swz_xor(float v) { return __int_as_float(__builtin_amdgcn_ds_swizzle(__float_as_int(v), (M << 10) | 0x1f)); }
struct Tensors { const bf16_t* Q; const bf16_t* K; const bf16_t* V; const bf16_t* Z; bf16_t* O; const float* rel_bias; const float* subln; };

#define DA_WAIT_BAR() asm volatile("s_waitcnt vmcnt(0) lgkmcnt(0)\n\ts_barrier" ::: "memory")
#define DA_SBAR() __builtin_amdgcn_sched_barrier(0)

template <int ST>
__device__ __forceinline__ void tile(DA_LAS unsigned char* lds, int tt, int qw, int r32, int hi, int kbase, int vb, const bf16x8 (&qr)[8], f32x16 (&o)[8], float& m_reg, float& l_reg,
                                     DA_LAS float* wsf, const DA_LAS float* tbl) {
    const int k0 = tt * 64;
    asm volatile("" : "+v"(kbase), "+v"(vb));
    f32x16 p0 = {}, p1 = {};
#pragma unroll
    for (int d0 = 0; d0 < 8; ++d0) { const int a = ST * STAGE + (kbase ^ (d0 << 5));
        const bf16x8 b0 = *(const DA_LAS bf16x8*)(lds + a), b1 = *(const DA_LAS bf16x8*)(lds + a + 8192);
        p0 = __builtin_amdgcn_mfma_f32_32x32x16_bf16(b0, qr[d0], p0, 0, 0, 0);
        p1 = __builtin_amdgcn_mfma_f32_32x32x16_bf16(b1, qr[d0], p1, 0, 0, 0); }
    if (k0 + 176 > qw) {
        const float NEG = -__builtin_inff(); const int dq = qw + r32 - k0 - 4 * hi;
#pragma unroll
        for (int r = 0; r < 16; ++r) { const int c = (r & 3) + 8 * (r >> 2); const int d_0 = dq - c, d_1 = d_0 - 32;
            const int i0 = d_0 < 0 ? 0 : (d_0 > 127 ? 127 : d_0), i1 = d_1 < 0 ? 0 : (d_1 > 127 ? 127 : d_1);
            const float b_0 = tbl[i0], b_1 = tbl[i1];
            p0[r] = d_0 < 0 ? NEG : p0[r] + b_0; p1[r] = d_1 < 0 ? NEG : p1[r] + b_1; }
    }
#define DA_MX3(a, b, c) __builtin_fmaxf(__builtin_fmaxf((a), (b)), (c))
    float pmA = DA_MX3(p0[0], p0[1], p0[2]), pmB = DA_MX3(p0[3], p0[4], p0[5]), pmC = DA_MX3(p1[0], p1[1], p1[2]), pmD = DA_MX3(p1[3], p1[4], p1[5]);
#pragma unroll
    for (int r = 6; r < 14; r += 4) { pmA = DA_MX3(pmA, p0[r], p0[r + 1]); pmB = DA_MX3(pmB, p0[r + 2], p0[r + 3]); pmC = DA_MX3(pmC, p1[r], p1[r + 1]); pmD = DA_MX3(pmD, p1[r + 2], p1[r + 3]); }
    pmA = DA_MX3(pmA, p0[14], p0[15]); pmC = DA_MX3(pmC, p1[14], p1[15]);
    float pmax = fmaxf(DA_MX3(pmA, pmB, pmC), pmD);
#undef DA_MX3
    { auto rr = __builtin_amdgcn_permlane32_swap(__float_as_uint(pmax), __float_as_uint(pmax), false, false); pmax = fmaxf(__uint_as_float(rr[0]), __uint_as_float(rr[1])); }
    if (!__all(pmax - m_reg <= THR)) {
        const float mn = fmaxf(m_reg, pmax); const float alpha = __builtin_amdgcn_exp2f(m_reg - mn); m_reg = mn; l_reg *= alpha;
        if (hi == 0) wsf[r32] = alpha;
        asm volatile("s_waitcnt lgkmcnt(0)" ::: "memory");
        float al[16];
#pragma unroll
        for (int r = 0; r < 16; ++r) al[r] = wsf[crow(r, hi)];
#pragma unroll
        for (int d0 = 0; d0 < 8; ++d0)
#pragma unroll
            for (int r = 0; r < 16; ++r) o[d0][r] *= al[r];
    }
    float ps = 0.f;
#pragma unroll
    for (int r = 0; r < 16; ++r) { p0[r] = __builtin_amdgcn_exp2f(p0[r] - m_reg); ps += p0[r]; }
#pragma unroll
    for (int r = 0; r < 16; ++r) { p1[r] = __builtin_amdgcn_exp2f(p1[r] - m_reg); ps += p1[r]; }
    l_reg += ps;
    bf16x8 pa0, pa1, pa2, pa3;
#define DA_PK4(P, B_, OUT) do { const unsigned a0 = cvtpk(P[B_ + 0], P[B_ + 1]), a1 = cvtpk(P[B_ + 2], P[B_ + 3]); \
        const unsigned b0 = cvtpk(P[B_ + 4], P[B_ + 5]), b1 = cvtpk(P[B_ + 6], P[B_ + 7]); \
        auto r0 = __builtin_amdgcn_permlane32_swap(a0, b0, false, false); auto r1 = __builtin_amdgcn_permlane32_swap(a1, b1, false, false); \
        u32x4 w = {r0[0], r1[0], r0[1], r1[1]}; OUT = __builtin_bit_cast(bf16x8, w); } while (0)
    DA_PK4(p0, 0, pa0); DA_PK4(p0, 8, pa1); DA_PK4(p1, 0, pa2); DA_PK4(p1, 8, pa3);
#undef DA_PK4
    const int vbs = vb + ST * STAGE;
#define DA_TRRD(dst, off) asm volatile("ds_read_b64_tr_b16 %0, %1 offset:%2" : "=&v"(dst) : "v"(vbs), "i"(off) : "memory")
#define DA_PV(d0) do { s16x4 l0, l1, l2, l3, h0, h1, h2, h3; constexpr int b_ = (d0) * 512; \
        DA_TRRD(l0, b_); DA_TRRD(h0, b_ + 4096); DA_TRRD(l1, b_ + 8192); DA_TRRD(h1, b_ + 12288); DA_TRRD(l2, b_ + 16384); DA_TRRD(h2, b_ + 20480); DA_TRRD(l3, b_ + 24576); DA_TRRD(h3, b_ + 28672); \
        asm volatile("s_waitcnt lgkmcnt(0)" ::: "memory"); DA_SBAR(); \
        o[d0] = __builtin_amdgcn_mfma_f32_32x32x16_bf16(pa0, (bf16x8){l0[0], l0[1], l0[2], l0[3], h0[0], h0[1], h0[2], h0[3]}, o[d0], 0, 0, 0); \
        o[d0] = __builtin_amdgcn_mfma_f32_32x32x16_bf16(pa1, (bf16x8){l1[0], l1[1], l1[2], l1[3], h1[0], h1[1], h1[2], h1[3]}, o[d0], 0, 0, 0); \
        o[d0] = __builtin_amdgcn_mfma_f32_32x32x16_bf16(pa2, (bf16x8){l2[0], l2[1], l2[2], l2[3], h2[0], h2[1], h2[2], h2[3]}, o[d0], 0, 0, 0); \
        o[d0] = __builtin_amdgcn_mfma_f32_32x32x16_bf16(pa3, (bf16x8){l3[0], l3[1], l3[2], l3[3], h3[0], h3[1], h3[2], h3[3]}, o[d0], 0, 0, 0); } while (0)
    DA_PV(0); DA_PV(1); DA_PV(2); DA_PV(3); DA_PV(4); DA_PV(5); DA_PV(6); DA_PV(7);
#undef DA_PV
#undef DA_TRRD
}

__device__ __forceinline__ void attn_unit(int h, int qb, const Tensors& T, float lam, DA_LAS unsigned char* lds, int wid) {
    const int lane = fresh_lane(), tid = wid * 64 + lane, r32 = lane & 31, hi = lane >> 5;
    const int rb = wid & 3, sh = wid >> 2;
    const int q0 = qb * 128, qw = q0 + rb * 32;
    const int NT = 2 * (qb + 1);
    const int ntw = (qw + 31) / 64 + 1;
    DA_LAS float* tbl = (DA_LAS float*)(lds + OFF_TBL);
    DA_LAS float* wsf = (DA_LAS float*)(lds + OFF_WS) + wid * 64;
    if (tid < 128) {
        const int n = tid; int bucket = n;
        if (n >= 16) { const float v = logf((float)n / 16.0f) / 2.0794415416798357f * 16.0f; const int lg = 16 + (int)v; bucket = lg < 31 ? lg : 31; }
        tbl[n] = (T.rel_bias[bucket * 16 + h] - T.rel_bias[31 * 16 + h]) * LOG2E;
    }
    const bool isK = wid < 4; const int wv = wid - 4;
    const unsigned laneK = (unsigned)((lane >> 4) * 8192 + (((lane & 15) ^ (lane >> 4)) << 4));
    const unsigned laneV = (unsigned)((8 * ((lane >> 4) & 1) + ((lane >> 2) & 3)) * 8192 + (lane >> 5) * 64 + (lane & 3) * 16);
    const unsigned laneoff = isK ? laneK : laneV;
    const bf16_t* gplane = isK ? T.K : T.V;
    const unsigned goff = (unsigned)h * 512u + (isK ? (unsigned)(wid >> 1) * 256u + (unsigned)((wid & 1) * 32) * 8192u : (unsigned)(16 * wv) * 8192u);
    const int dst0 = isK ? (wid >> 1) * 16384 + (wid & 1) * 8192 : OFF_V + wv * 8192;
#define DA_DMA(t_, st_) do { _Pragma("unroll") for (int i_ = 0; i_ < 8; ++i_) { \
        const unsigned uo_ = goff + (unsigned)(t_) * (64u * 8192u) + (isK ? (unsigned)(i_ * 32768) : (unsigned)((i_ >> 2) * 32768 + (i_ & 3) * 128)); \
        const unsigned lo_ = (laneoff ^ (isK ? (unsigned)((i_ & 3) << 6) : 0u)) + uo_; \
        const unsigned ld_ = (unsigned)(uintptr_t)lds + (unsigned)((st_) * STAGE + dst0 + i_ * 1024); unsigned keep_; \
        asm volatile("s_mov_b32 %0, m0\n\ts_mov_b32 m0, %3\n\ts_nop 0\n\tglobal_load_lds_dwordx4 %1, %2\n\ts_mov_b32 m0, %0" : "=&s"(keep_) : "v"(lo_), "s"(gplane), "s"(ld_) : "memory"); } } while (0)
    DA_DMA(0, 0);
    const bf16_t* Qw = T.Q + (size_t)(qw + r32) * PITCH + h * 256 + sh * 128 + hi * 8;
    bf16x8 qr[8];
#pragma unroll
    for (int d0 = 0; d0 < 8; ++d0) qr[d0] = *(const bf16x8*)(Qw + d0 * 16);
    const int kbase = sh * 16384 + r32 * 256 + (((r32 & 15) ^ hi) << 4);
    const int vb = (int)(uintptr_t)lds + OFF_V + v_rd_base(lane);
    float m_reg = -1e30f, l_reg = 0.f;
    f32x16 o[8];
#pragma unroll
    for (int d0 = 0; d0 < 8; ++d0) o[d0] = f32x16{};
    for (int t = 0; t < NT; t += 2) {
        DA_WAIT_BAR();
        DA_DMA(t + 1, 1);
        if (t < ntw) tile<0>(lds, t, qw, r32, hi, kbase, vb, qr, o, m_reg, l_reg, wsf, tbl);
        DA_WAIT_BAR();
        if (t + 2 < NT) DA_DMA(t + 2, 0);
        if (t + 1 < ntw) tile<1>(lds, t + 1, qw, r32, hi, kbase, vb, qr, o, m_reg, l_reg, wsf, tbl);
    }
#undef DA_DMA
    { auto rr = __builtin_amdgcn_permlane32_swap(__float_as_uint(l_reg), __float_as_uint(l_reg), false, false); l_reg = __uint_as_float(rr[0]) + __uint_as_float(rr[1]); }
    if (hi == 0) wsf[r32] = 1.0f / l_reg;
    asm volatile("s_waitcnt lgkmcnt(0)" ::: "memory");
    float rli[16];
#pragma unroll
    for (int r = 0; r < 16; ++r) rli[r] = wsf[crow(r, hi)];
#pragma unroll
    for (int d0 = 0; d0 < 8; ++d0)
#pragma unroll
        for (int r = 0; r < 16; ++r) o[d0][r] *= rli[r];
    DA_WAIT_BAR();
    DA_LAS f32x4* X4 = (DA_LAS f32x4*)(lds + rb * 32768);
    if (sh == 1) { const float nl = -lam;
#pragma unroll
        for (int d0 = 0; d0 < 8; ++d0) {
#pragma unroll
            for (int j = 0; j < 4; ++j) { f32x4 v; v[0] = o[d0][4 * j] * nl; v[1] = o[d0][4 * j + 1] * nl; v[2] = o[d0][4 * j + 2] * nl; v[3] = o[d0][4 * j + 3] * nl;
                X4[(d0 * 4 + j) * 64 + lane] = v; }
            DA_SBAR(); }
    }
    DA_WAIT_BAR();
    if (sh == 0) {
        u32x4 zq[16];
#pragma unroll
        for (int pass = 0; pass < 16; ++pass) zq[pass] = *(const u32x4*)(T.Z + (size_t)(qw + 2 * pass + hi) * PITCH + h * 256 + r32 * 8);
#pragma unroll
        for (int d0 = 0; d0 < 8; ++d0)
#pragma unroll
            for (int j = 0; j < 4; ++j) { const f32x4 v = X4[(d0 * 4 + j) * 64 + lane]; o[d0][4 * j] += v[0]; o[d0][4 * j + 1] += v[1]; o[d0][4 * j + 2] += v[2]; o[d0][4 * j + 3] += v[3]; if (j == 3) DA_SBAR(); }
        float rs[16];
#pragma unroll
        for (int r = 0; r < 16; ++r) { float s = 0.f;
#pragma unroll
            for (int d0 = 0; d0 < 8; ++d0) s += o[d0][r] * o[d0][r];
            s += swz_xor<1>(s); s += swz_xor<2>(s); s += swz_xor<4>(s); s += swz_xor<8>(s); s += swz_xor<16>(s);
            rs[r] = 0.8f / sqrtf(s * (1.0f / 256.0f) + 1e-5f); }
        float gn[8];
#pragma unroll
        for (int d0 = 0; d0 < 8; ++d0) gn[d0] = T.subln[d0 * 32 + r32];
        asm volatile("s_waitcnt lgkmcnt(0)" ::: "memory");
        DA_LAS float* Y = (DA_LAS float*)(lds + rb * 32768);
#pragma unroll
        for (int d0 = 0; d0 < 8; ++d0)
#pragma unroll
            for (int r = 0; r < 16; ++r) Y[crow(r, hi) * 256 + d0 * 32 + r32] = o[d0][r] * rs[r] * gn[d0];
        asm volatile("s_waitcnt lgkmcnt(0)" ::: "memory");
#pragma unroll
        for (int pass = 0; pass < 16; ++pass) { const int row = 2 * pass + hi;
            const DA_LAS f32x4* yp = (const DA_LAS f32x4*)(Y + row * 256 + r32 * 8); const f32x4 y0 = yp[0], y1 = yp[1];
            const size_t go = (size_t)(qw + row) * PITCH + h * 256 + r32 * 8;
            const u32x4 zz = zq[pass];
            u32x4 w;
            w.x = cvtpk(y0[0] * silu(__uint_as_float(zz.x << 16)), y0[1] * silu(__uint_as_float(zz.x & 0xffff0000u)));
            w.y = cvtpk(y0[2] * silu(__uint_as_float(zz.y << 16)), y0[3] * silu(__uint_as_float(zz.y & 0xffff0000u)));
            w.z = cvtpk(y1[0] * silu(__uint_as_float(zz.z << 16)), y1[1] * silu(__uint_as_float(zz.z & 0xffff0000u)));
            w.w = cvtpk(y1[2] * silu(__uint_as_float(zz.w << 16)), y1[3] * silu(__uint_as_float(zz.w & 0xffff0000u)));
            *(u32x4*)(T.O + go) = w; }
    }
    DA_WAIT_BAR();
}

__device__ __forceinline__ void attn_phase(DA_LAS unsigned char* lds, const Tensors& T, const float* lamp, int vcu, int G, int wid) {
    const int lane = fresh_lane();
    float s1 = lamp[lane] * lamp[128 + lane] + lamp[64 + lane] * lamp[192 + lane];
    float s2 = lamp[256 + lane] * lamp[384 + lane] + lamp[320 + lane] * lamp[448 + lane];
#pragma unroll
    for (int o_ = 1; o_ < 64; o_ <<= 1) { s1 += __shfl_xor(s1, o_); s2 += __shfl_xor(s2, o_); }
    const float lam = __int_as_float(__builtin_amdgcn_readfirstlane(__float_as_int(expf(s1) - expf(s2) + 0.2f)));
    const int nit = (G == 256) ? 4 : (vcu < 1024 ? (1024 - vcu + G - 1) / G : 0);
    for (int u = 0; u < 2 * nit; ++u) {
        const int i = u >> 1; int h, pi;
        if (G == 256) { h = 2 * (vcu >> 5) + (i >> 1); pi = (i & 1) * 32 + (vcu & 31); }
        else { const int p = vcu + i * G; h = p >> 6; pi = p & 63; }
        attn_unit(h, (u & 1) ? pi : 127 - pi, T, lam, lds, wid);
    }
}
#undef DA_WAIT_BAR
#undef DA_SBAR
}
#define GAS __attribute__((address_space(1)))
#define LAS __attribute__((address_space(3)))
typedef unsigned short bf16;
typedef unsigned v4u __attribute__((ext_vector_type(4)));
typedef float f32x4 __attribute__((ext_vector_type(4)));
typedef short bf16x8 __attribute__((ext_vector_type(8)));
typedef GAS unsigned gu32;
typedef GAS unsigned long long gu64;
#define RLX_AGENT __ATOMIC_RELAXED, __HIP_MEMORY_SCOPE_AGENT
#define LDS_WAIT() asm volatile("s_waitcnt lgkmcnt(0)" ::: "memory")
#define VM_WAIT() asm volatile("s_waitcnt vmcnt(0)" ::: "memory")
__device__ __forceinline__ unsigned long long rt() { return __builtin_amdgcn_s_memrealtime(); }
__device__ __forceinline__ unsigned f2bf(float f) { unsigned u = __builtin_bit_cast(unsigned, f); return (u + 0x7fffu + ((u >> 16) & 1u)) >> 16; }
__device__ __forceinline__ unsigned pk2(float lo, float hi) { unsigned r; asm("v_cvt_pk_bf16_f32 %0, %1, %2" : "=v"(r) : "v"(lo), "v"(hi)); return r; }

#define XB_TMO      128
#define XB_XCNT(j)  (256  + 64 * (j))
#define XB_XSUB(j)  (1280 + 64 * (j))
#define XB_XGEN(j)  (2304 + 64 * (j))
#define XB_TOP      3328
#define XB_TOPGEN   3392
#define XCD_BAR_WORDS 3456
#define XB_SPIN_CAP (1u << 18)

__device__ __forceinline__ unsigned xb_ld(unsigned* p)              { return __hip_atomic_load(p, __ATOMIC_RELAXED, __HIP_MEMORY_SCOPE_AGENT); }
__device__ __forceinline__ unsigned xb_add(unsigned* p, unsigned v) { return __hip_atomic_fetch_add(p, v, __ATOMIC_RELAXED, __HIP_MEMORY_SCOPE_AGENT); }
__device__ __forceinline__ unsigned xb_xcc_id() { return (unsigned)__builtin_amdgcn_s_getreg((3 << 11) | 20) & 0xFu; }
#define XB_SPIN(cond, bar) do { unsigned _sp = 0; while (cond) { __builtin_amdgcn_s_sleep(1); \
    if ((++_sp & 255u) == 0u) { if (xb_ld(&(bar)[XB_TMO])) break; if (_sp > XB_SPIN_CAP) { atomicAdd(&(bar)[XB_TMO], 1u); break; } } } } while (0)

struct XcdBarrier {
    unsigned* bar; unsigned x;
    volatile LAS unsigned* st;
};

__device__ __forceinline__ XcdBarrier xcd_barrier_post(unsigned* bar, volatile LAS unsigned* st) {
    XcdBarrier b; b.bar = bar; b.x = xb_xcc_id(); b.st = st;
    if (threadIdx.x == 0) (void)xb_add(&bar[XB_XCNT(b.x)], 1u);
    return b;
}
__device__ __forceinline__ void xcd_barrier_complete(unsigned* bar, unsigned x, unsigned& nloc, unsigned& nx) {
    const unsigned G = gridDim.x * gridDim.y * gridDim.z;
    unsigned sum, cnt, mine, sp = 0u;
    for (;;) {
        sum = 0u; cnt = 0u; mine = 0u;
#pragma unroll
        for (unsigned j = 0; j < 16; ++j) { const unsigned c = xb_ld(&bar[XB_XCNT(j)]); sum += c; cnt += (c > 0u) ? 1u : 0u; mine = (j == x) ? c : mine; }
        if (sum == G) break;
        __builtin_amdgcn_s_sleep(1);
        if ((++sp & 255u) == 0u) { if (xb_ld(&bar[XB_TMO])) break; if (sp > XB_SPIN_CAP) { atomicAdd(&bar[XB_TMO], 1u); break; } }
    }
    nloc = mine > 0u ? mine : 1u; nx = cnt > 0u ? cnt : 1u;
}

__device__ __forceinline__ void xcd_barrier(const XcdBarrier& b, const int wave_) {
    asm volatile("s_waitcnt vmcnt(0)" ::: "memory");
    __syncthreads();
    int lane_; asm volatile("v_mbcnt_lo_u32_b32 %0, -1, 0\n\tv_mbcnt_hi_u32_b32 %0, -1, %0" : "=v"(lane_));
    if (wave_ == 0 && lane_ == 0) {
        unsigned* bar = b.bar;
        __builtin_amdgcn_s_waitcnt(0);
        unsigned nloc = b.st[0], nx = b.st[1];
        if (nloc == 0u) { xcd_barrier_complete(bar, b.x, nloc, nx); b.st[0] = nloc; b.st[1] = nx; }
        const unsigned old = xb_add(&bar[XB_XSUB(b.x)], 1u);
        const unsigned gen = old / nloc;
        if (old + 1u == (gen + 1u) * nloc) {
            __builtin_amdgcn_fence(__ATOMIC_RELEASE, "agent");
            asm volatile("s_waitcnt vmcnt(0)" ::: "memory");
            const unsigned og = xb_add(&bar[XB_TOP], 1u);
            const unsigned tg = og / nx;
            if (og + 1u == (tg + 1u) * nx) xb_add(&bar[XB_TOPGEN], 1u);
            else XB_SPIN(xb_ld(&bar[XB_TOPGEN]) == tg, bar);
            __builtin_amdgcn_fence(__ATOMIC_ACQUIRE, "agent");
            xb_add(&bar[XB_XGEN(b.x)], 1u);
            asm volatile("s_waitcnt vmcnt(0)" ::: "memory");
        } else {
            XB_SPIN(xb_ld(&bar[XB_XGEN(b.x)]) == gen, bar);
            __builtin_amdgcn_fence(__ATOMIC_ACQUIRE, "agent");
            asm volatile("s_waitcnt vmcnt(0)" ::: "memory");
        }
    }
    __syncthreads();
}
constexpr int NWAVES = 8;
constexpr int SEQ = 16384, DM = 4096, NH = 16, AW = 4096, PW = 8192, PGD = 2048;
constexpr float NORM_EPS = 1e-6f;
#ifndef MK_N_LAUNCHES
#define MK_N_LAUNCHES 1
#endif
constexpr int N_PHASES = 9;

constexpr size_t MiB = 1u << 20;
constexpr size_t WS_CTL = 0, CTL_ZERO_BYTES = 256 * 1024;
constexpr size_t WS_SS1 = 64 * 1024, WS_SS2 = 128 * 1024;
constexpr size_t WS_SS0 = 256 * 1024;
constexpr size_t WS_WO1 = 2 * MiB, WS_WG = 34 * MiB, WS_WO2 = 66 * MiB, WS_W2 = 130 * MiB;
constexpr size_t WS_Q = 258 * MiB, WS_K = 386 * MiB, WS_V = 514 * MiB, WS_Z = 642 * MiB, WS_O = 770 * MiB;
constexpr size_t WS_YF = 386 * MiB, WS_YL = 418 * MiB;
constexpr size_t WS_Z2 = 642 * MiB;
constexpr size_t WS_WINU = 898 * MiB;
constexpr size_t WS_END = 962 * MiB;
constexpr size_t OUT_W1 = 0, OUT_XB = 128 * MiB;
constexpr int CW_TMO = 0, CW_BAR = 4096, CW_PANEL = 8192;

constexpr int RING_BYTES = 131072;
constexpr int LDS_BYTES = 163840;
constexpr int MISC_OFF = LDS_BYTES - 256;
static_assert(dattn::LDS_END <= MISC_OFF && 8 * 64 * 65 * 4 <= MISC_OFF, "LDS map");

__device__ __forceinline__ float wave_sum(float v) {
#pragma unroll
    for (int o = 1; o < 64; o <<= 1) v += __shfl_xor(v, o);
    return v;
}
__device__ __forceinline__ void transpose_item(const float* W, int N, int nblk, bf16* WT, int ldt, const float* gain, LAS float* scr, int item, int lane) {
    const int kb = item / nblk, nb = item - kb * nblk, k0 = kb * 64, n0 = nb * 64;
    const int lr = lane >> 4, lc = (lane & 15) * 4;
    f32x4 ld[16];
#pragma unroll
    for (int i = 0; i < 16; ++i) ld[i] = *(const f32x4*)(W + (size_t)(k0 + 4 * i + lr) * N + n0 + lc);
#pragma unroll
    for (int i = 0; i < 16; ++i) { const int kk = 4 * i + lr; f32x4 v = ld[i];
        if (gain) { const float g = gain[k0 + kk]; v = v * g; }
        LAS float* s = scr + kk * 65 + lc; s[0] = v[0]; s[1] = v[1]; s[2] = v[2]; s[3] = v[3]; }
    LDS_WAIT(); asm volatile("" ::: "memory");
    const int c = lane & 7;
#pragma unroll 2
    for (int j = 0; j < 8; ++j) { const int n = (lane >> 3) + 8 * j; const LAS float* s = scr + (8 * c) * 65 + n;
        v4u o; o.x = pk2(s[0 * 65], s[1 * 65]); o.y = pk2(s[2 * 65], s[3 * 65]); o.z = pk2(s[4 * 65], s[5 * 65]); o.w = pk2(s[6 * 65], s[7 * 65]);
        *(v4u*)(WT + (size_t)(n0 + n) * ldt + k0 + 8 * c) = o; }
    LDS_WAIT(); asm volatile("" ::: "memory");
}

__device__ __forceinline__ void unpack8(const v4u q, float (&f)[8]) {
    f[0] = __uint_as_float(q.x << 16); f[1] = __uint_as_float(q.x & 0xffff0000u); f[2] = __uint_as_float(q.y << 16); f[3] = __uint_as_float(q.y & 0xffff0000u);
    f[4] = __uint_as_float(q.z << 16); f[5] = __uint_as_float(q.z & 0xffff0000u); f[6] = __uint_as_float(q.w << 16); f[7] = __uint_as_float(q.w & 0xffff0000u); }
struct Args { const float* in[12]; float* out; unsigned char* ws; int ph_lo, ph_hi; };

__global__ void __launch_bounds__(NWAVES * 64, 2) hybrid_fwd(Args args) {
    extern __shared__ __attribute__((aligned(16))) unsigned char lds_raw[];
    LAS unsigned char* lds = (LAS unsigned char*)lds_raw;
    volatile LAS unsigned* MISC = (volatile LAS unsigned*)(lds + MISC_OFF);
    const int tid0 = threadIdx.x, wave = __builtin_amdgcn_readfirstlane(tid0 >> 6);
    const int G = gridDim.x; const int bx = blockIdx.x; const int vcu = (G % 8 == 0) ? (bx % 8) * (G / 8) + bx / 8 : bx;
    unsigned char* ws = args.ws; unsigned char* outb = (unsigned char*)args.out;
    const float* x = args.in[0]; const float* norm_gains = args.in[1]; const float* final_gain = args.in[2]; const float* rel_bias = args.in[3];
    const float* attn_w_in = args.in[4]; const float* attn_lambda = args.in[5]; const float* attn_subln = args.in[6]; const float* attn_w_out = args.in[7];
    const float* pool_w_in = args.in[8]; const float* pool_w_group = args.in[9]; const float* pool_scale = args.in[10]; const float* pool_w_out = args.in[11];
    unsigned* ctl = (unsigned*)(ws + WS_CTL);
    float* ss0 = (float*)(ws + WS_SS0); float* ss1 = (float*)(ws + WS_SS1); float* ss2 = (float*)(ws + WS_SS2);
    bf16* W1t = (bf16*)(outb + OUT_W1); bf16* XB = (bf16*)(outb + OUT_XB);
    bf16* Wo1t = (bf16*)(ws + WS_WO1); bf16* Wgt = (bf16*)(ws + WS_WG); bf16* Wo2t = (bf16*)(ws + WS_WO2); bf16* W2t = (bf16*)(ws + WS_W2);
    bf16* Qp = (bf16*)(ws + WS_Q); bf16* Kp = (bf16*)(ws + WS_K); bf16* Vp = (bf16*)(ws + WS_V); bf16* Zp = (bf16*)(ws + WS_Z); bf16* Op = (bf16*)(ws + WS_O);
    bf16* WinU = (bf16*)(ws + WS_WINU);
    bf16* XB1 = Qp; bf16* Z2p = (bf16*)(ws + WS_Z2);
    float* xres = args.out;

    if (tid0 < 64) ((LAS unsigned*)(lds + MISC_OFF))[tid0] = 0u;
    __syncthreads();
    XcdBarrier bar; bar.bar = ctl + CW_BAR; bar.x = 0; bar.st = nullptr;
    if (MK_N_LAUNCHES == 1) bar = xcd_barrier_post(ctl + CW_BAR, MISC);
    const int lo = args.ph_lo, hi = args.ph_hi;
#define IN(k) (lo <= (k) && (k) < hi)
#define GRID_BAR(k) do { if (IN((k) + 1)) xcd_barrier(bar, wave); } while (0)

    if (IN(0)) {
        const int lane = dattn::fresh_lane();
        LAS float* scr = (LAS float*)lds + wave * (64 * 65);
        const int gw = vcu * NWAVES + wave, NGW = G * NWAVES;
        constexpr int I_W1 = (DM / 64) * (4 * AW / 64), I_WO1 = (AW / 64) * (DM / 64), I_W2Z = (DM / 64) * (PW / 64), I_WG = (PGD / 64) * (PGD / 64), I_WO2 = (PW / 64) * (DM / 64);
        constexpr int NITEMS = I_W1 + I_WO1 + I_W2Z + 4 * I_WG + I_WO2;
        for (int it = gw; it < NITEMS; it += NGW) {
            int r = it;
            if (r < I_W1) { transpose_item(attn_w_in, 4 * AW, 4 * AW / 64, W1t, DM, norm_gains, scr, r, lane); continue; } r -= I_W1;
            if (r < I_WO1) { transpose_item(attn_w_out, DM, DM / 64, Wo1t, AW, nullptr, scr, r, lane); continue; } r -= I_WO1;
            if (r < I_W2Z) { const int n0 = (r % (PW / 64)) * 64;
                transpose_item(pool_w_in + PW, 2 * PW, PW / 64, W2t + (size_t)((n0 >> 7) * 128 + 128) * DM, DM, norm_gains + DM, scr, r, lane); continue; } r -= I_W2Z;
            if (r < 4 * I_WG) { const int g = r / I_WG; transpose_item(pool_w_group + (size_t)g * PGD * PGD, PGD, PGD / 64, Wgt + (size_t)g * PGD * PGD, PGD, nullptr, scr, r - g * I_WG, lane); continue; } r -= 4 * I_WG;
            transpose_item(pool_w_out, DM, DM / 64, Wo2t, PW, nullptr, scr, r, lane);
        }
        {
            const int gt0 = gw * 64 + lane, NT0 = NGW * 64;
            for (int i0 = gt0; i0 < DM * (PW / 8); i0 += 4 * NT0) {
                f32x4 a[4], b4[4];
#pragma unroll
                for (int u = 0; u < 4; ++u) { const int i = i0 + u * NT0; if (i < DM * (PW / 8)) { const int k = i >> 10, c8 = (i & 1023) * 8;
                    a[u] = *(const f32x4*)(pool_w_in + (size_t)k * (2 * PW) + c8); b4[u] = *(const f32x4*)(pool_w_in + (size_t)k * (2 * PW) + c8 + 4); } }
#pragma unroll
                for (int u = 0; u < 4; ++u) { const int i = i0 + u * NT0; if (i < DM * (PW / 8)) { const int k = i >> 10, c8 = (i & 1023) * 8; const float gk = norm_gains[DM + k];
                    v4u o; o.x = pk2(a[u][0] * gk, a[u][1] * gk); o.y = pk2(a[u][2] * gk, a[u][3] * gk); o.z = pk2(b4[u][0] * gk, b4[u][1] * gk); o.w = pk2(b4[u][2] * gk, b4[u][3] * gk);
                    *(v4u*)(WinU + (size_t)k * PW + c8) = o; } } }
        }
        for (int m = gw; m < SEQ; m += NGW) {
            const f32x4* xr = (const f32x4*)(x + (size_t)m * DM) + lane; unsigned long long* o8 = (unsigned long long*)(XB + (size_t)m * DM) + lane; float s = 0.f;
            f32x4 xv[16];
#pragma unroll
            for (int j = 0; j < 16; ++j) xv[j] = xr[64 * j];
#pragma unroll
            for (int j = 0; j < 16; ++j) { const f32x4 v = xv[j]; s += (v[0] * v[0] + v[1] * v[1]) + (v[2] * v[2] + v[3] * v[3]);
                o8[64 * j] = (unsigned long long)pk2(v[0], v[1]) | ((unsigned long long)pk2(v[2], v[3]) << 32); }
            s = wave_sum(s); if (lane == 0) ss0[m] = s;
        }
        GRID_BAR(0);
    }
    if (IN(1)) {
        pg8::Gemm g{Wgt, WinU, PW, DM, PGD, PGD, PW, -1, 0, 3, PGD * 2}; pg8::StaticOrder S; S.init(PW, DM, G, bx);
        pg8::EpiPlain E{W2t, DM, 1};
        pg8::gemm_phase<pg8::EpiPlain, pg8::StaticOrder, true, true>(lds, g, S, E, wave);
    }
    if (IN(2)) {
        pg8::Gemm g{XB, W1t, SEQ, 4 * AW, DM, DM, DM, -1, 0, -1, 0}; pg8::StaticOrder S; S.init(SEQ, 4 * AW, G, bx);
        pg8::EpiNormSplit E{Qp, ss0, AW, (size_t)(WS_K - WS_Q) / 2, dattn::QSCALE, NORM_EPS, -1, 1.0f};
        pg8::gemm_phase<pg8::EpiNormSplit, pg8::StaticOrder, true, true>(lds, g, S, E, wave);
        GRID_BAR(2);
    }
    if (IN(3)) {
        const dattn::Tensors T{Qp, Kp, Vp, Zp, Op, rel_bias, attn_subln};
        dattn::attn_phase(lds, T, attn_lambda, vcu, G, wave);
        GRID_BAR(3);
    }
    if (IN(4)) {
        pg8::Gemm g{Op, Wo1t, SEQ, DM, AW, AW, AW, -1, 0, -1, 0};
        pg8::EpiResid E{x, nullptr, nullptr, XB1, ss1, DM};
        { pg8::StaticOrder S; S.init(SEQ, DM, G, bx); pg8::gemm_phase<pg8::EpiResid, pg8::StaticOrder, true, true>(lds, g, S, E, wave); }
        GRID_BAR(4);
    }
    bf16* MZp = (bf16*)(ws + WS_Z2); bf16* Yf = (bf16*)(ws + WS_YF); bf16* Yl = (bf16*)(ws + WS_YL);
    if (IN(5)) {
        pg8::Gemm g{XB1, W2t, SEQ, 2 * PW, DM, DM, DM, -1, 0, -1, 0}; pg8::StaticOrder S; S.init(SEQ, 2 * PW, G, bx);
        pg8::EpiPool E{MZp, Yf, Yl, ss1, pool_scale, lds + RING_BYTES, NORM_EPS};
        pg8::gemm_phase<pg8::EpiPool, pg8::StaticOrder, true, true>(lds, g, S, E, wave);
        GRID_BAR(5);
    }
    if (IN(6)) {
        const int gt = vcu * (NWAVES * 64) + wave * 64 + dattn::fresh_lane(), NT_ = G * NWAVES * 64;
        for (int task = gt; task < (SEQ / 256) * (PW / 8); task += NT_) {
            const int cc = task & 1023, pm = __builtin_amdgcn_readfirstlane(task >> 10), w = 2 << __builtin_amdgcn_readfirstlane(cc >> 8);
            const bf16* yp = Yl + ((size_t)(pm - 1) * 16) * PW + (size_t)cc * 8; const bf16* yc = Yf + ((size_t)pm * 16) * PW + (size_t)cc * 8; bf16* mz = MZp + ((size_t)pm * 256) * PW + (size_t)cc * 8;
            const f32x4 sc0 = *(const f32x4*)(pool_scale + cc * 8), sc1 = *(const f32x4*)(pool_scale + cc * 8 + 4);
            float scv[8], s[8];
#pragma unroll
            for (int e = 0; e < 8; ++e) { scv[e] = (e < 4 ? sc0[e] : sc1[e - 4]) * 0.6931471805599453f; s[e] = 0.f; }
            for (int r = 16 - w + 1; r < 16; ++r) if (pm > 0) { float f[8]; unpack8(*(const v4u*)(yp + (size_t)r * PW), f);
#pragma unroll
                for (int e = 0; e < 8; ++e) s[e] += f[e]; }
            for (int r = 0; r < 16; ++r) {
                float u[8], o_[8], z[8], a[8]; unpack8(*(const v4u*)(yc + (size_t)r * PW), u); unpack8(*(const v4u*)(mz + (size_t)r * PW), z);
#pragma unroll
                for (int e = 0; e < 8; ++e) { s[e] += u[e]; o_[e] = 0.f; }
                const int cnt = (pm == 0 && r + 1 < w) ? r + 1 : w; const float ic = 1.0f / (float)cnt;
#pragma unroll
                for (int e = 0; e < 8; ++e) a[e] = (s[e] * ic - u[e]) * scv[e] * (z[e] * __builtin_amdgcn_rcpf(1.0f + __builtin_amdgcn_exp2f(-z[e])));
                v4u o; o.x = pk2(a[0], a[1]); o.y = pk2(a[2], a[3]); o.z = pk2(a[4], a[5]); o.w = pk2(a[6], a[7]);
                *(v4u*)(mz + (size_t)r * PW) = o;
                const int ro = r + 1 - w;
                if (ro >= 0) unpack8(*(const v4u*)(yc + (size_t)ro * PW), o_); else if (pm > 0) unpack8(*(const v4u*)(yp + (size_t)(16 + ro) * PW), o_);
#pragma unroll
                for (int e = 0; e < 8; ++e) s[e] -= o_[e];
            }
        }
        GRID_BAR(6);
    }
    const bool fused_tail = (MK_N_LAUNCHES == 1) && (G % (DM / 256) == 0);
    if (IN(7)) {
        pg8::Gemm g{Z2p, Wo2t, SEQ, DM, PW, PW, PW, -1, 0, -1, 0};
        if (fused_tail) {
            pg8::PanelOrder S; S.init(SEQ, DM, G, vcu);
            pg8::EpiFinal E{XB1, xres, ss2, ctl + CW_PANEL, ctl + CW_BAR + XB_TMO, final_gain, DM, NORM_EPS, (unsigned)(DM / 256)};
            pg8::gemm_phase<pg8::EpiFinal, pg8::PanelOrder, true, true>(lds, g, S, E, wave);
        } else {
            pg8::StaticOrder S; S.init(SEQ, DM, G, bx);
            pg8::EpiResid E{nullptr, XB1, xres, nullptr, ss2, DM};
            pg8::gemm_phase<pg8::EpiResid, pg8::StaticOrder, true, true>(lds, g, S, E, wave);
            GRID_BAR(7);
        }
    }
    if (IN(8) && !fused_tail) {
        const int gt = vcu * (NWAVES * 64) + wave * 64 + dattn::fresh_lane(), NT_ = G * NWAVES * 64;
        const bool bad = (MK_N_LAUNCHES == 1) && (__hip_atomic_load(ctl + CW_BAR + XB_TMO, __ATOMIC_RELAXED, __HIP_MEMORY_SCOPE_AGENT) != 0u);
        const float qnan = __builtin_nanf("");
        for (int i0 = gt; i0 < SEQ * (DM / 4); i0 += 8 * NT_) {
            f32x4 v[8]; float sq[8];
#pragma unroll
            for (int u = 0; u < 8; ++u) { const int i = i0 + u * NT_; if (i < SEQ * (DM / 4)) { v[u] = ((const f32x4*)xres)[i]; sq[u] = ss2[i >> 10]; } }
#pragma unroll
            for (int u = 0; u < 8; ++u) { const int i = i0 + u * NT_; if (i < SEQ * (DM / 4)) { const float rs = 1.0f / sqrtf(sq[u] * (1.0f / 4096.0f) + NORM_EPS);
                const f32x4 gg = ((const f32x4*)final_gain)[i & 1023]; f32x4 r = v[u] * rs * gg; if (bad) r = (f32x4){qnan, qnan, qnan, qnan};
                ((f32x4*)xres)[i] = r; } } }
    }
#undef IN
#undef GRID_BAR
}

extern "C" void kernel_launch(void* const* d_in, const int* in_sizes, int n_in, void* d_out, int out_size, void* d_ws, size_t ws_size, hipStream_t stream) {
    static int grid = 0;
    if (grid == 0) {
        if (n_in != 12 || in_sizes[0] != SEQ * DM || out_size != SEQ * DM || ws_size < WS_END) {
            fprintf(stderr, "kernel_launch: built for 12 inputs, x/out of %d floats, >= %zu bytes of workspace; got n_in %d, in0 %d, out %d, ws %zu; nothing launched\n", SEQ * DM, (size_t)WS_END, n_in, n_in > 0 ? in_sizes[0] : -1, out_size, ws_size); grid = -1; return; }
        int dev = 0, cus = 0, per_cu = 0;
        if (hipGetDevice(&dev) != hipSuccess || hipDeviceGetAttribute(&cus, hipDeviceAttributeMultiprocessorCount, dev) != hipSuccess) { fprintf(stderr, "kernel_launch: device query failed\n"); grid = -1; return; }
        if (hipFuncSetAttribute((const void*)hybrid_fwd, hipFuncAttributeMaxDynamicSharedMemorySize, LDS_BYTES) != hipSuccess) { fprintf(stderr, "kernel_launch: hipFuncSetAttribute failed\n"); grid = -1; return; }
        if (hipOccupancyMaxActiveBlocksPerMultiprocessor(&per_cu, (const void*)hybrid_fwd, NWAVES * 64, LDS_BYTES) != hipSuccess || per_cu < 1)
            fprintf(stderr, "kernel_launch: note: occupancy query reports %d workgroups per CU\n", per_cu);
        (void)hipGetLastError();
        grid = cus;
    }
    if (grid < 0) return;
    if (hipMemsetAsync((char*)d_ws + WS_CTL, 0, CTL_ZERO_BYTES, stream) != hipSuccess) { fprintf(stderr, "kernel_launch: hipMemsetAsync failed\n"); return; }
    Args a{};
    for (int i = 0; i < 12; ++i) a.in[i] = (const float*)d_in[i];
    a.out = (float*)d_out; a.ws = (unsigned char*)d_ws;
    for (int li = 0; li < MK_N_LAUNCHES; ++li) {
        a.ph_lo = (MK_N_LAUNCHES == 1) ? 0 : li; a.ph_hi = (MK_N_LAUNCHES == 1) ? N_PHASES : li + 1;
        hipLaunchKernelGGL(hybrid_fwd, dim3(grid), dim3(NWAVES * 64), LDS_BYTES, stream, a);
        const hipError_t le = hipPeekAtLastError();
        if (le != hipSuccess) { fprintf(stderr, "kernel_launch: launch %d failed: %s\n", li, hipGetErrorName(le)); break; }
    }
}
```

```cpp
#include <hip/hip_runtime.h>
#include <cstdio>
#include <cstdint>
#include <cmath>
namespace pg8 {
#define PG8_LAS __attribute__((address_space(3)))
typedef unsigned short bf16_t;
typedef short bf16x8 __attribute__((ext_vector_type(8)));
typedef float f32x4 __attribute__((ext_vector_type(4)));
typedef unsigned u32x4 __attribute__((ext_vector_type(4)));
typedef unsigned u32x2 __attribute__((ext_vector_type(2)));
constexpr int BM = 256, BK = 64, HALF = 128, HTB = HALF * BK * 2  , STAGE_BYTES = 8 * HTB, NXCD = 8, WGM = 4;

__host__ __device__ __forceinline__ int lds_byte(int r, int c) { const int st = (r >> 4) * 2 + (c >> 5), rr = r & 15, cc = c & 31, ob = rr * 64 + cc * 2; return st * 1024 + (ob ^ (((ob >> 9) & 1) << 5)); }
__host__ __device__ __forceinline__ void stage_rc(int b, int& R, int& C) { const int st = b / 1024, sb = b % 1024, swz = sb ^ (((sb >> 9) & 1) << 5); R = (st >> 1) * 16 + swz / 64; C = (st & 1) * 32 + (swz % 64) / 2; }
__host__ __device__ __forceinline__ int perm32(int rho) { const int n = rho >> 4, i = rho & 15; return 8 * (i >> 2) + 4 * n + (i & 3); }

struct Unit { int pm, pn; };
struct Gemm { const bf16_t* A; const bf16_t* Bt; int M, N, K, lda, ldb, gshift, gstride, bshift, bstride;
    __device__ __forceinline__ size_t aoff(int pn) const { return gshift >= 0 ? (size_t)(pn >> gshift) * (size_t)gstride : (size_t)0; }
    __device__ __forceinline__ size_t boff(int pm) const { return bshift >= 0 ? (size_t)(pm >> bshift) * (size_t)bstride : (size_t)0; } };

struct StaticOrder {
    int nM, nN, nwg, G, c;
    __host__ __device__ void init(int M, int N, int G_, int c_) { nM = M / BM; nN = N / BM; nwg = nM * nN; G = G_; c = c_; }
    __host__ __device__ bool next(int i, Unit& u) const {
        const long L = (long)i * G + c; if (L >= nwg) return false;
        int wgid = (int)L; { const int q = nwg / NXCD, r = nwg % NXCD, xcd = wgid % NXCD, off = wgid / NXCD; wgid = (xcd < r ? xcd * (q + 1) : r * (q + 1) + (xcd - r) * q) + off; }
        const int nig = WGM * nN, gid = wgid / nig, fm = gid * WGM, gsz = (nM - fm) < WGM ? (nM - fm) : WGM;
        u.pm = fm + ((wgid % nig) % gsz); u.pn = (wgid % nig) / gsz; return true;
    }
    __device__ __forceinline__ void a_ready(const Unit&) const {}
    __device__ __forceinline__ void done(const Unit&) const {}
};

struct PanelOrder {
    int nN, nwg, G, c;
    __host__ __device__ void init(int M, int N, int G_, int c_) { nN = N / BM; nwg = (M / BM) * nN; G = G_; c = c_; }
    __host__ __device__ bool next(int i, Unit& u) const {
        const long L0 = (long)i * G; if (L0 + c >= nwg) return false;
        if (nN % 16 == 0 && G % 64 == 0 && nwg % G == 0 && ((nwg / nN) % (G / 16)) == 0) {
            const int ncs = nN / 16, rg = i / ncs, sc = i - rg * ncs;
            const int q = c >> 6, h = (c >> 5) & 1, j = c & 31;
            u.pm = rg * (G / 16) + q * 4 + (j & 3); u.pn = sc * 16 + h * 8 + (j >> 2); return true; }
        const long L = L0 + c; u.pm = (int)(L / nN); u.pn = (int)(L % nN); return true;
    }
    __device__ __forceinline__ void a_ready(const Unit&) const {}
    __device__ __forceinline__ void done(const Unit&) const {}
};

__device__ __forceinline__ unsigned cvt_pk_bf16(float lo, float hi) { unsigned r; asm volatile("v_cvt_pk_bf16_f32 %0, %1, %2" : "=v"(r) : "v"(lo), "v"(hi)); return r; }
typedef float f32x2 __attribute__((ext_vector_type(2)));
template <class Epi, class Sched, bool ALIGN_EPI = false, bool SP2 = false>
__device__ __forceinline__ void gemm_phase(PG8_LAS unsigned char* lds, const Gemm g, const Sched& S, const Epi& E, const int wid) {
    int lane; asm volatile("v_mbcnt_lo_u32_b32 %0, -1, 0\n\tv_mbcnt_hi_u32_b32 %0, -1, %0" : "=v"(lane));
    const int tid = wid * 64 + lane, wr = wid >> 2, wc = wid & 3, fr = lane & 15, fq = lane >> 4;
    const int K = g.K, nt = K / BK;
    unsigned voffA[2], voffB[2];
#pragma unroll
    for (int i = 0; i < 2; ++i) { int R, C; stage_rc(tid * 16 + i * 8192, R, C); const int Rb = Epi::PERM ? ((R & ~31) + perm32(R & 31)) : R;
        voffA[i] = (unsigned)(R * g.lda + C) * 2u; voffB[i] = (unsigned)(Rb * g.ldb + C) * 2u; }
    const size_t kstep = (size_t)(BK * 2);
    const size_t hstepA = (size_t)HALF * g.lda * 2, hstepB = (size_t)HALF * g.ldb * 2;
    const size_t tstepA = 2 * hstepA, tstepB = 2 * hstepB;
    const unsigned ldsw = (unsigned)wid * 1024u;
    const int aoff = lds_byte(wr * 64 + fr, fq * 8), boff = lds_byte(wc * 32 + fr, fq * 8);
#define PG8_SA(b, h) (((b) * 2 + (h)) * HTB)
#define PG8_SB(b, h) ((4 + (b) * 2 + (h)) * HTB)
#define PG8_STAGE(bufoff, gbase, voff) do { _Pragma("unroll") for (int _i = 0; _i < 2; ++_i) \
        __builtin_amdgcn_global_load_lds((const unsigned*)((const char*)(gbase) + (voff)[_i]), (PG8_LAS unsigned*)(lds + (bufoff) + ldsw + _i * 8192), 16, 0, 0); } while (0)
#define PG8_LDA(dst, b, h) do { _Pragma("unroll") for (int m = 0; m < 4; ++m) _Pragma("unroll") for (int k = 0; k < 2; ++k) dst[m][k] = *(const PG8_LAS bf16x8*)(lds + PG8_SA(b, h) + aoff + m * 2048 + k * 1024); } while (0)
#define PG8_LDB(dst, b, h) do { _Pragma("unroll") for (int n = 0; n < 2; ++n) _Pragma("unroll") for (int k = 0; k < 2; ++k) dst[n][k] = *(const PG8_LAS bf16x8*)(lds + PG8_SB(b, h) + boff + n * 2048 + k * 1024); } while (0)
#define PG8_MMA(ai, bj, At, Bt) do { __builtin_amdgcn_s_setprio(1); _Pragma("unroll") for (int m = 0; m < 4; ++m) _Pragma("unroll") for (int n = 0; n < 2; ++n) _Pragma("unroll") for (int k = 0; k < 2; ++k) \
        acc[ai][bj][m][n] = (Epi::YNT && (bj) == 0) ? __builtin_amdgcn_mfma_f32_16x16x32_bf16(At[m][k], Bt[n][k], acc[ai][bj][m][n], 0, 0, 0) : __builtin_amdgcn_mfma_f32_16x16x32_bf16(Bt[n][k], At[m][k], acc[ai][bj][m][n], 0, 0, 0); __builtin_amdgcn_s_setprio(0); } while (0)
#define PG8_WAIT_V(n) asm volatile("s_waitcnt vmcnt(" #n ")" ::: "memory")
#define PG8_WAIT_L(n) asm volatile("s_waitcnt lgkmcnt(" #n ")" ::: "memory")
#define PG8_BAR __builtin_amdgcn_s_barrier()
#define PG8_SCHED __builtin_amdgcn_sched_barrier(0)
    Unit cur, nxt; int ui = 0;
    if (!S.next(0, cur)) return;
    f32x4 acc[2][2][4][2];
#pragma unroll
    for (int a = 0; a < 2; ++a)
#pragma unroll
        for (int b = 0; b < 2; ++b)
#pragma unroll
            for (int m = 0; m < 4; ++m)
#pragma unroll
                for (int n = 0; n < 2; ++n) acc[a][b][m][n] = (f32x4){0.f, 0.f, 0.f, 0.f};
    bf16x8 At[4][2], B0[2][2], B1[2][2];
    const char* cA = (const char*)g.A + (size_t)cur.pm * tstepA + g.aoff(cur.pn); const char* cB = (const char*)g.Bt + (size_t)cur.pn * tstepB + g.boff(cur.pm);
    S.a_ready(cur);
    if constexpr (SP2) {
        PG8_STAGE(PG8_SB(0, 0), cB, voffB); PG8_STAGE(PG8_SB(0, 1), cB + hstepB, voffB); PG8_STAGE(PG8_SA(0, 0), cA, voffA); PG8_STAGE(PG8_SA(0, 1), cA + hstepA, voffA);
        if (wr == 1) PG8_BAR;
        PG8_WAIT_V(2); PG8_BAR;
        PG8_STAGE(PG8_SB(1, 0), cB + kstep, voffB); PG8_STAGE(PG8_SA(1, 0), cA + kstep, voffA); PG8_STAGE(PG8_SB(1, 1), cB + hstepB + kstep, voffB);
        PG8_WAIT_V(6); PG8_BAR;
    } else {
        PG8_STAGE(PG8_SB(0, 0), cB, voffB); PG8_STAGE(PG8_SA(0, 0), cA, voffA); PG8_STAGE(PG8_SB(0, 1), cB + hstepB, voffB); PG8_STAGE(PG8_SA(0, 1), cA + hstepA, voffA);
        if (wr == 1) PG8_BAR;
        PG8_WAIT_V(4); PG8_BAR;
        PG8_STAGE(PG8_SB(1, 0), cB + kstep, voffB); PG8_STAGE(PG8_SA(1, 0), cA + kstep, voffA); PG8_STAGE(PG8_SB(1, 1), cB + hstepB + kstep, voffB);
        PG8_WAIT_V(6); PG8_BAR;
    }
    for (;;) {
        const bool has_next = S.next(ui + 1, nxt);
        const char* nA = has_next ? (const char*)g.A + (size_t)nxt.pm * tstepA + g.aoff(nxt.pn) : cA; const char* nB = has_next ? (const char*)g.Bt + (size_t)nxt.pn * tstepB + g.boff(nxt.pm) : cB;
        for (int t = 0; t < nt; t += 2) {
            const bool last = (t == nt - 2);
            const char* a1 = cA + (size_t)(t + 1) * kstep;
            const char* a2 = last ? nA : cA + (size_t)(t + 2) * kstep; const char* b2 = last ? nB : cB + (size_t)(t + 2) * kstep;
            const char* a3 = a2 + kstep; const char* b3 = b2 + kstep;
            if (last && has_next) S.a_ready(nxt);
            if constexpr (SP2) {
            PG8_LDB(B0, 0, 0); PG8_LDB(B1, 0, 1); PG8_SCHED; PG8_LDA(At, 0, 0); PG8_STAGE(PG8_SA(1, 1), a1 + hstepA, voffA);
            PG8_WAIT_V(8); PG8_WAIT_L(0); PG8_BAR; PG8_MMA(0, 0, At, B0); PG8_MMA(0, 1, At, B1); PG8_BAR; PG8_SCHED;
            PG8_LDA(At, 0, 1); PG8_STAGE(PG8_SB(0, 0), b2, voffB); PG8_STAGE(PG8_SB(0, 1), b2 + hstepB, voffB); PG8_STAGE(PG8_SA(0, 0), a2, voffA);
            PG8_WAIT_V(8); PG8_WAIT_L(0); PG8_BAR; PG8_MMA(1, 0, At, B0); PG8_MMA(1, 1, At, B1); PG8_BAR; PG8_SCHED;
            PG8_LDB(B0, 1, 0); PG8_LDB(B1, 1, 1); PG8_SCHED; PG8_LDA(At, 1, 0); PG8_STAGE(PG8_SA(0, 1), a2 + hstepA, voffA);
            PG8_WAIT_V(8); PG8_WAIT_L(0); PG8_BAR; PG8_MMA(0, 0, At, B0); PG8_MMA(0, 1, At, B1); PG8_BAR; PG8_SCHED;
            PG8_LDA(At, 1, 1); PG8_STAGE(PG8_SB(1, 0), b3, voffB); PG8_STAGE(PG8_SB(1, 1), b3 + hstepB, voffB); PG8_STAGE(PG8_SA(1, 0), a3, voffA);
            PG8_WAIT_V(8); PG8_WAIT_L(0); PG8_BAR; PG8_MMA(1, 0, At, B0); PG8_MMA(1, 1, At, B1); PG8_BAR; PG8_SCHED;
            } else {
            PG8_LDB(B0, 0, 0); PG8_SCHED; PG8_LDA(At, 0, 0); PG8_STAGE(PG8_SA(1, 1), a1 + hstepA, voffA);
            PG8_WAIT_L(8); PG8_BAR; PG8_WAIT_L(0); PG8_MMA(0, 0, At, B0); PG8_BAR; PG8_SCHED;
            PG8_LDB(B1, 0, 1); PG8_STAGE(PG8_SB(0, 0), b2, voffB);
            PG8_BAR; PG8_WAIT_L(0); PG8_MMA(0, 1, At, B1); PG8_BAR;
            PG8_LDA(At, 0, 1); PG8_STAGE(PG8_SA(0, 0), a2, voffA);
            PG8_BAR; PG8_WAIT_L(0); PG8_MMA(1, 0, At, B0); PG8_BAR; PG8_SCHED;
            PG8_STAGE(PG8_SB(0, 1), b2 + hstepB, voffB);
            PG8_WAIT_V(6); PG8_BAR; PG8_MMA(1, 1, At, B1); PG8_BAR;
            PG8_LDB(B0, 1, 0); PG8_SCHED; PG8_LDA(At, 1, 0); PG8_STAGE(PG8_SA(0, 1), a2 + hstepA, voffA);
            PG8_WAIT_L(8); PG8_BAR; PG8_WAIT_L(0); PG8_MMA(0, 0, At, B0); PG8_BAR; PG8_SCHED;
            PG8_LDB(B1, 1, 1); PG8_STAGE(PG8_SB(1, 0), b3, voffB);
            PG8_BAR; PG8_WAIT_L(0); PG8_MMA(0, 1, At, B1); PG8_BAR;
            PG8_LDA(At, 1, 1); PG8_STAGE(PG8_SA(1, 0), a3, voffA);
            PG8_BAR; PG8_WAIT_L(0); PG8_MMA(1, 0, At, B0); PG8_BAR; PG8_SCHED;
            PG8_STAGE(PG8_SB(1, 1), b3 + hstepB, voffB);
            PG8_WAIT_V(6); PG8_BAR; PG8_MMA(1, 1, At, B1); PG8_BAR;
            }
        }
        if constexpr (ALIGN_EPI) { if (wr == 0) PG8_BAR; }
        if constexpr (!Epi::AFTER_DRAIN) { E(acc, cur, wr, wc, fr, fq); S.done(cur); }
        if (!has_next) break;
#pragma unroll
        for (int a = 0; a < 2; ++a)
#pragma unroll
            for (int b = 0; b < 2; ++b)
#pragma unroll
                for (int m = 0; m < 4; ++m)
#pragma unroll
                    for (int n = 0; n < 2; ++n) acc[a][b][m][n] = (f32x4){0.f, 0.f, 0.f, 0.f};
        cur = nxt; cA = nA; cB = nB; ++ui;
        if constexpr (ALIGN_EPI) { if (wr == 1) PG8_BAR; }
    }
    PG8_WAIT_V(0);
    if constexpr (!ALIGN_EPI) { if (wr == 0) PG8_BAR; }
    PG8_BAR;
    if constexpr (Epi::AFTER_DRAIN) { E.fused(acc, cur, wr, wc, fr, fq, lds, wid, lane); S.done(cur); }
#undef PG8_SA
#undef PG8_SB
#undef PG8_STAGE
#undef PG8_LDA
#undef PG8_LDB
#undef PG8_MMA
#undef PG8_WAIT_V
#undef PG8_WAIT_L
#undef PG8_BAR
#undef PG8_SCHED
}
}
namespace pg8 {
__device__ __forceinline__ u32x4 pack8_bf16(const f32x4 v0, const f32x4 v1) { u32x4 w; w.x = cvt_pk_bf16(v0[0], v0[1]); w.y = cvt_pk_bf16(v0[2], v0[3]); w.z = cvt_pk_bf16(v1[0], v1[1]); w.w = cvt_pk_bf16(v1[2], v1[3]); return w; }

struct EpiNormSplit {
    static constexpr bool PERM = true, AFTER_DRAIN = false, YNT = false;
    bf16_t* O; const float* ss; int split_cols; size_t split_stride; float scale0; float eps; int zplane; float scalez;
    __device__ __forceinline__ void operator()(const f32x4 (&acc)[2][2][4][2], const Unit& u, int wr, int wc, int fr, int fq) const {
        const int row0 = u.pm * BM + wr * 64 + fr; int colt = u.pn * BM; bf16_t* base = O;
        const int t = colt / split_cols; base += (size_t)t * split_stride; colt -= t * split_cols;
        const float sc = (t == 0) ? scale0 : ((t == zplane) ? scalez : 1.f);
        const int col0 = colt + wc * 32 + 8 * fq;
#pragma unroll
        for (int ai = 0; ai < 2; ++ai)
#pragma unroll
            for (int m = 0; m < 4; ++m) { const int row = row0 + ai * HALF + m * 16;
                const float rs = sc * __builtin_amdgcn_rsqf(ss[row] * (1.0f / 4096.0f) + eps);
                bf16_t* rowp = base + (size_t)row * split_cols + col0;
#pragma unroll
                for (int bj = 0; bj < 2; ++bj) { const f32x4 v0 = acc[ai][bj][m][0] * rs, v1 = acc[ai][bj][m][1] * rs; *(u32x4*)(rowp + bj * HALF) = pack8_bf16(v0, v1); } }
    }
};

struct EpiPlain {
    static constexpr bool PERM = true, AFTER_DRAIN = false, YNT = false;
    bf16_t* O; int ldc; int ymap;
    __device__ __forceinline__ void operator()(const f32x4 (&acc)[2][2][4][2], const Unit& u, int wr, int wc, int fr, int fq) const {
        const int row0 = u.pm * BM + wr * 64 + fr, col0 = u.pn * BM + wc * 32 + 8 * fq;
#pragma unroll
        for (int ai = 0; ai < 2; ++ai)
#pragma unroll
            for (int m = 0; m < 4; ++m) { int row = row0 + ai * HALF + m * 16; if (ymap) row = ((row >> 7) << 8) + (row & 127);
                bf16_t* rowp = O + (size_t)row * ldc + col0;
#pragma unroll
                for (int bj = 0; bj < 2; ++bj) *(u32x4*)(rowp + bj * HALF) = pack8_bf16(acc[ai][bj][m][0], acc[ai][bj][m][1]); }
    }
};

struct EpiResid {
    static constexpr bool PERM = true, AFTER_DRAIN = false, YNT = false;
    const float* base; const bf16_t* baseh; float* out; bf16_t* xb; float* ss; int ldc;
    __device__ __forceinline__ void operator()(const f32x4 (&acc)[2][2][4][2], const Unit& u, int wr, int wc, int fr, int fq) const {
        const int row0 = u.pm * BM + wr * 64 + fr, col0 = u.pn * BM + wc * 32 + 8 * fq;
#pragma unroll
        for (int ai = 0; ai < 2; ++ai)
#pragma unroll
            for (int m = 0; m < 4; ++m) { const int row = row0 + ai * HALF + m * 16; const size_t off = (size_t)row * ldc + col0; float sq = 0.f;
#pragma unroll
                for (int bj = 0; bj < 2; ++bj) { f32x4 b0, b1;
                    if (base) { const float* bp = base + off + bj * HALF; b0 = *(const f32x4*)bp; b1 = *(const f32x4*)(bp + 4); }
                    else { const u32x4 hq = *(const u32x4*)(baseh + off + bj * HALF);
                        b0[0] = __uint_as_float(hq.x << 16); b0[1] = __uint_as_float(hq.x & 0xffff0000u); b0[2] = __uint_as_float(hq.y << 16); b0[3] = __uint_as_float(hq.y & 0xffff0000u);
                        b1[0] = __uint_as_float(hq.z << 16); b1[1] = __uint_as_float(hq.z & 0xffff0000u); b1[2] = __uint_as_float(hq.w << 16); b1[3] = __uint_as_float(hq.w & 0xffff0000u); }
                    const f32x4 v0 = acc[ai][bj][m][0] + b0, v1 = acc[ai][bj][m][1] + b1;
                    if (out) { *(f32x4*)(out + off + bj * HALF) = v0; *(f32x4*)(out + off + bj * HALF + 4) = v1; }
                    sq += (v0[0] * v0[0] + v0[1] * v0[1]) + (v0[2] * v0[2] + v0[3] * v0[3]) + (v1[0] * v1[0] + v1[1] * v1[1]) + (v1[2] * v1[2] + v1[3] * v1[3]);
                    if (xb) *(u32x4*)(xb + off + bj * HALF) = pack8_bf16(v0, v1); }
                sq += __shfl_xor(sq, 16); sq += __shfl_xor(sq, 32);
                if (fq == 0) unsafeAtomicAdd(ss + row, sq); }
    }
};

struct EpiPool {
    static constexpr bool PERM = true, AFTER_DRAIN = false, YNT = true;
    bf16_t* MZ; bf16_t* Yf; bf16_t* Yl; const float* ss; const float* pscale; PG8_LAS unsigned char* xl; float eps;
    __device__ __forceinline__ void operator()(const f32x4 (&acc)[2][2][4][2], const Unit& u, int wr, int wc, int fr, int fq) const {
        constexpr int LDC = 8192;
        const int wid = wr * 4 + wc, lane = fq * 16 + fr;
        const int w = 2 << (u.pn >> 4);
        const int rowb = u.pm * BM + wr * 64, colb = u.pn * HALF + wc * 32 + 8 * fq;
        PG8_LAS float* RS = (PG8_LAS float*)xl + wid * 128;
        PG8_LAS u32x2* HALO = (PG8_LAS u32x2*)(xl + 4096);
        float rst[2][4];
#pragma unroll
        for (int ai = 0; ai < 2; ++ai)
#pragma unroll
            for (int m = 0; m < 4; ++m) { rst[ai][m] = __builtin_amdgcn_rsqf(ss[rowb + ai * HALF + m * 16 + fr] * (1.0f / 4096.0f) + eps); if (fq == 0) RS[(ai * 4 + m) * 16 + fr] = rst[ai][m]; }
        asm volatile("s_waitcnt lgkmcnt(0)" ::: "memory");
        u32x2 ypk[2][4][2];
#pragma unroll
        for (int ai = 0; ai < 2; ++ai)
#pragma unroll
            for (int m = 0; m < 4; ++m) { const f32x4 rn = *(const PG8_LAS f32x4*)(RS + (ai * 4 + m) * 16 + 4 * fq);
#pragma unroll
                for (int n = 0; n < 2; ++n) { const f32x4 v = acc[ai][0][m][n] * rn; ypk[ai][m][n].x = cvt_pk_bf16(v[0], v[1]); ypk[ai][m][n].y = cvt_pk_bf16(v[2], v[3]); } }
#pragma unroll
        for (int n = 0; n < 2; ++n) {
            if (wr == 0) { HALO[((0 * 4 + wc) * 2 + n) * 64 + lane] = ypk[0][3][n]; HALO[((2 * 4 + wc) * 2 + n) * 64 + lane] = ypk[1][3][n]; }
            else HALO[((1 * 4 + wc) * 2 + n) * 64 + lane] = ypk[0][3][n]; }
        asm volatile("s_waitcnt lgkmcnt(0)" ::: "memory");
        __syncthreads();
        u32x2 hal[2][2];
#pragma unroll
        for (int n = 0; n < 2; ++n) {
            hal[0][n] = (u32x2){0u, 0u}; if (wr == 1) hal[0][n] = HALO[((0 * 4 + wc) * 2 + n) * 64 + lane];
            hal[1][n] = HALO[(((wr == 0 ? 1 : 2) * 4 + wc) * 2 + n) * 64 + lane]; }
        const float invw = 1.0f / (float)w;
        float cp[4], cc[4], ci[4];
#pragma unroll
        for (int e = 0; e < 4; ++e) { const int p = 4 * fq + e, dp = fr + 16 - p, dc = fr - p;
            cp[e] = (dp < w) ? invw : 0.f; cc[e] = (dc == 0) ? invw - 1.0f : ((dc > 0 && dc < w) ? invw : 0.f); ci[e] = (dc == 0) ? 1.0f : 0.f; }
        u32x4 bpw, biw; bpw.x = cvt_pk_bf16(cp[0], cp[1]); bpw.y = cvt_pk_bf16(cp[2], cp[3]); bpw.z = cvt_pk_bf16(cc[0], cc[1]); bpw.w = cvt_pk_bf16(cc[2], cc[3]);
        biw.x = 0u; biw.y = 0u; biw.z = cvt_pk_bf16(ci[0], ci[1]); biw.w = cvt_pk_bf16(ci[2], ci[3]);
        const bf16x8 bp = __builtin_bit_cast(bf16x8, bpw), bi = __builtin_bit_cast(bf16x8, biw);
        const f32x4 ps0 = *(const f32x4*)(pscale + colb) * 0.6931471805599453f, ps1 = *(const f32x4*)(pscale + colb + 4) * 0.6931471805599453f;
        const f32x4 zero4 = (f32x4){0.f, 0.f, 0.f, 0.f};
        float zf; asm volatile("v_mov_b32 %0, 0" : "=v"(zf));
#pragma unroll
        for (int ai = 0; ai < 2; ++ai)
#pragma unroll
            for (int m = 0; m < 4; ++m) {
                const int row = rowb + ai * HALF + m * 16 + fr; bf16_t* dst = MZ + (size_t)row * LDC + colb;
                const float zs = rst[ai][m] * 1.4426950408889634f;
                f32x4 z0 = acc[ai][1][m][0] * zs, z1 = acc[ai][1][m][1] * zs;
                const bool first = (ai == 0 && m == 0) && (wr == 0), lastb = (ai == 1 && m == 3) && (wr == 1);
                if (first || lastb) {
                    u32x4 a0, a1; a0.x = 0u; a0.y = 0u; a0.z = ypk[ai][m][0].x; a0.w = ypk[ai][m][0].y; a1.x = 0u; a1.y = 0u; a1.z = ypk[ai][m][1].x; a1.w = ypk[ai][m][1].y;
                    const f32x4 y0 = __builtin_amdgcn_mfma_f32_16x16x32_bf16(__builtin_bit_cast(bf16x8, a0), bi, zero4, 0, 0, 0), y1 = __builtin_amdgcn_mfma_f32_16x16x32_bf16(__builtin_bit_cast(bf16x8, a1), bi, zero4, 0, 0, 0);
                    bf16_t* yd = (first ? Yf : Yl) + ((size_t)u.pm * 16 + fr) * LDC + colb;
                    *(u32x4*)yd = pack8_bf16(y0 + zf, y1 + zf); }
                if (first) { *(u32x4*)dst = pack8_bf16(z0, z1); }
                else {
                    const u32x2 pv0 = (m > 0) ? ypk[ai][m > 0 ? m - 1 : 0][0] : hal[ai][0], pv1 = (m > 0) ? ypk[ai][m > 0 ? m - 1 : 0][1] : hal[ai][1];
                    u32x4 a0, a1; a0.x = pv0.x; a0.y = pv0.y; a0.z = ypk[ai][m][0].x; a0.w = ypk[ai][m][0].y; a1.x = pv1.x; a1.y = pv1.y; a1.z = ypk[ai][m][1].x; a1.w = ypk[ai][m][1].y;
                    f32x4 d0 = __builtin_amdgcn_mfma_f32_16x16x32_bf16(__builtin_bit_cast(bf16x8, a0), bp, zero4, 0, 0, 0), d1 = __builtin_amdgcn_mfma_f32_16x16x32_bf16(__builtin_bit_cast(bf16x8, a1), bp, zero4, 0, 0, 0);
#pragma unroll
                    for (int e = 0; e < 4; ++e) { d0[e] *= ps0[e] * (z0[e] * __builtin_amdgcn_rcpf(1.0f + __builtin_amdgcn_exp2f(-z0[e]))); d1[e] *= ps1[e] * (z1[e] * __builtin_amdgcn_rcpf(1.0f + __builtin_amdgcn_exp2f(-z1[e]))); }
                    *(u32x4*)dst = pack8_bf16(d0, d1); }
            }
    }
};

struct EpiFinal {
    static constexpr bool PERM = true, AFTER_DRAIN = false, YNT = false;
    const bf16_t* baseh; float* out; float* ss; unsigned* cnt; unsigned* tmo; const float* gain; int ldc; float eps; unsigned nown;
    __device__ __forceinline__ void base8(const size_t off, f32x4& b0, f32x4& b1) const { const u32x4 hq = *(const u32x4*)(baseh + off);
        b0[0] = __uint_as_float(hq.x << 16); b0[1] = __uint_as_float(hq.x & 0xffff0000u); b0[2] = __uint_as_float(hq.y << 16); b0[3] = __uint_as_float(hq.y & 0xffff0000u);
        b1[0] = __uint_as_float(hq.z << 16); b1[1] = __uint_as_float(hq.z & 0xffff0000u); b1[2] = __uint_as_float(hq.w << 16); b1[3] = __uint_as_float(hq.w & 0xffff0000u); }
    __device__ __forceinline__ void operator()(const f32x4 (&acc)[2][2][4][2], const Unit& u, int wr, int wc, int fr, int fq) const {
        const int row0 = u.pm * BM + wr * 64 + fr, col0 = u.pn * BM + wc * 32 + 8 * fq;
#pragma unroll
        for (int ai = 0; ai < 2; ++ai)
#pragma unroll
            for (int m = 0; m < 4; ++m) { const int row = row0 + ai * HALF + m * 16; const size_t off = (size_t)row * ldc + col0; float sq = 0.f;
#pragma unroll
                for (int bj = 0; bj < 2; ++bj) { f32x4 b0, b1; base8(off + bj * HALF, b0, b1);
                    const f32x4 v0 = acc[ai][bj][m][0] + b0, v1 = acc[ai][bj][m][1] + b1;
                    sq += (v0[0] * v0[0] + v0[1] * v0[1]) + (v0[2] * v0[2] + v0[3] * v0[3]) + (v1[0] * v1[0] + v1[1] * v1[1]) + (v1[2] * v1[2] + v1[3] * v1[3]); }
                sq += __shfl_xor(sq, 16); sq += __shfl_xor(sq, 32);
                if (fq == 0) unsafeAtomicAdd(ss + row, sq); }
        asm volatile("s_waitcnt vmcnt(0)" ::: "memory");
        __syncthreads();
        if (wr == 0 && wc == 0 && fr == 0 && fq == 0) {
            unsigned* c = cnt + u.pm;
            (void)__hip_atomic_fetch_add(c, 1u, __ATOMIC_RELAXED, __HIP_MEMORY_SCOPE_AGENT);
            unsigned sp = 0u;
            while (__hip_atomic_load(c, __ATOMIC_RELAXED, __HIP_MEMORY_SCOPE_AGENT) < nown) { __builtin_amdgcn_s_sleep(1);
                if ((++sp & 255u) == 0u) { if (__hip_atomic_load(tmo, __ATOMIC_RELAXED, __HIP_MEMORY_SCOPE_AGENT)) break; if (sp > (1u << 18)) { atomicAdd(tmo, 1u); break; } } }
        }
        __syncthreads();
        const bool bad = __hip_atomic_load(tmo, __ATOMIC_RELAXED, __HIP_MEMORY_SCOPE_AGENT) != 0u;
        const float qnan = __builtin_nanf("");
        f32x4 gg[2][2];
#pragma unroll
        for (int bj = 0; bj < 2; ++bj)
#pragma unroll
            for (int n = 0; n < 2; ++n) gg[bj][n] = *(const f32x4*)(gain + col0 + bj * HALF + 4 * n);
#pragma unroll
        for (int ai = 0; ai < 2; ++ai)
#pragma unroll
            for (int m = 0; m < 4; ++m) { const int row = row0 + ai * HALF + m * 16; const size_t off = (size_t)row * ldc + col0;
                const float ssv = __hip_atomic_load(ss + row, __ATOMIC_RELAXED, __HIP_MEMORY_SCOPE_AGENT);
                const float rs = bad ? qnan : __builtin_amdgcn_rsqf(ssv * (1.0f / 4096.0f) + eps);
#pragma unroll
                for (int bj = 0; bj < 2; ++bj) { f32x4 b0, b1; base8(off + bj * HALF, b0, b1);
                    const f32x4 v0 = (acc[ai][bj][m][0] + b0) * rs * gg[bj][0], v1 = (acc[ai][bj][m][1] + b1) * rs * gg[bj][1];
                    *(f32x4*)(out + off + bj * HALF) = v0; *(f32x4*)(out + off + bj * HALF + 4) = v1; } }
    }
};

}
namespace dattn {
#define DA_LAS __attribute__((address_space(3)))
typedef unsigned short bf16_t;
typedef short bf16x8 __attribute__((ext_vector_type(8)));
typedef short s16x4 __attribute__((ext_vector_type(4)));
typedef float f32x16 __attribute__((ext_vector_type(16)));
typedef float f32x4 __attribute__((ext_vector_type(4)));
typedef unsigned u32x4 __attribute__((ext_vector_type(4)));
constexpr int PITCH = 4096;
constexpr int STAGE = 65536, OFF_V = 32768;
constexpr int OFF_TBL = 131072, OFF_WS = OFF_TBL + 512, LDS_END = OFF_WS + 8 * 256;
constexpr float LOG2E = 1.4426950408889634f;
constexpr float THR = 8.0f;
constexpr float QSCALE = 0.08838834764831845f * LOG2E;

__device__ __forceinline__ int crow(int r, int hi) { return (r & 3) + 8 * (r >> 2) + 4 * hi; }
__device__ __forceinline__ unsigned cvtpk(float lo, float hi) { unsigned r; asm volatile("v_cvt_pk_bf16_f32 %0, %1, %2" : "=v"(r) : "v"(lo), "v"(hi)); return r; }
__device__ __forceinline__ int v_rd_base(int lane) { return ((lane & 3) << 3) | (((lane >> 2) & 3) << 6) | (((lane >> 4) & 1) << 5) | (((lane >> 5) & 1) << 8); }
__device__ __forceinline__ float silu(float z) { return z * __builtin_amdgcn_rcpf(1.0f + __builtin_amdgcn_exp2f(-LOG2E * z)); }

__device__ __forceinline__ int fresh_lane() { int l; asm volatile("v_mbcnt_lo_u32_b32 %0, -1, 0\n\tv_mbcnt_hi_u32_b32 %0, -1, %0" : "=v"(l)); return l; }
template <int M> __device__ __forceinline__ float swz_xor(float v) { return __int_as_float(__builtin_amdgcn_ds_swizzle(__float_as_int(v), (M << 10) | 0x1f)); }
struct Tensors { const bf16_t* Q; const bf16_t* K; const bf16_t* V; const bf16_t* Z; bf16_t* O; const float* rel_bias; const float* subln; };

#define DA_WAIT_BAR() asm volatile("s_waitcnt vmcnt(0) lgkmcnt(0)\n\ts_barrier" ::: "memory")
#define DA_SBAR() __builtin_amdgcn_sched_barrier(0)

template <int ST>
__device__ __forceinline__ void tile(DA_LAS unsigned char* lds, int tt, int qw, int r32, int hi, int kbase, int vb, const bf16x8 (&qr)[8], f32x16 (&o)[8], float& m_reg, float& l_reg,
                                     DA_LAS float* wsf, const DA_LAS float* tbl) {
    const int k0 = tt * 64;
    asm volatile("" : "+v"(kbase), "+v"(vb));
    f32x16 p0 = {}, p1 = {};
#pragma unroll
    for (int d0 = 0; d0 < 8; ++d0) { const int a = ST * STAGE + (kbase ^ (d0 << 5));
        const bf16x8 b0 = *(const DA_LAS bf16x8*)(lds + a), b1 = *(const DA_LAS bf16x8*)(lds + a + 8192);
        p0 = __builtin_amdgcn_mfma_f32_32x32x16_bf16(b0, qr[d0], p0, 0, 0, 0);
        p1 = __builtin_amdgcn_mfma_f32_32x32x16_bf16(b1, qr[d0], p1, 0, 0, 0); }
    if (k0 + 176 > qw) {
        const float NEG = -__builtin_inff(); const int dq = qw + r32 - k0 - 4 * hi;
#pragma unroll
        for (int r = 0; r < 16; ++r) { const int c = (r & 3) + 8 * (r >> 2); const int d_0 = dq - c, d_1 = d_0 - 32;
            const int i0 = d_0 < 0 ? 0 : (d_0 > 127 ? 127 : d_0), i1 = d_1 < 0 ? 0 : (d_1 > 127 ? 127 : d_1);
            const float b_0 = tbl[i0], b_1 = tbl[i1];
            p0[r] = d_0 < 0 ? NEG : p0[r] + b_0; p1[r] = d_1 < 0 ? NEG : p1[r] + b_1; }
    }
#define DA_MX3(a, b, c) __builtin_fmaxf(__builtin_fmaxf((a), (b)), (c))
    float pmA = DA_MX3(p0[0], p0[1], p0[2]), pmB = DA_MX3(p0[3], p0[4], p0[5]), pmC = DA_MX3(p1[0], p1[1], p1[2]), pmD = DA_MX3(p1[3], p1[4], p1[5]);
#pragma unroll
    for (int r = 6; r < 14; r += 4) { pmA = DA_MX3(pmA, p0[r], p0[r + 1]); pmB = DA_MX3(pmB, p0[r + 2], p0[r + 3]); pmC = DA_MX3(pmC, p1[r], p1[r + 1]); pmD = DA_MX3(pmD, p1[r + 2], p1[r + 3]); }
    pmA = DA_MX3(pmA, p0[14], p0[15]); pmC = DA_MX3(pmC, p1[14], p1[15]);
    float pmax = fmaxf(DA_MX3(pmA, pmB, pmC), pmD);
#undef DA_MX3
    { auto rr = __builtin_amdgcn_permlane32_swap(__float_as_uint(pmax), __float_as_uint(pmax), false, false); pmax = fmaxf(__uint_as_float(rr[0]), __uint_as_float(rr[1])); }
    if (!__all(pmax - m_reg <= THR)) {
        const float mn = fmaxf(m_reg, pmax); const float alpha = __builtin_amdgcn_exp2f(m_reg - mn); m_reg = mn; l_reg *= alpha;
        if (hi == 0) wsf[r32] = alpha;
        asm volatile("s_waitcnt lgkmcnt(0)" ::: "memory");
        float al[16];
#pragma unroll
        for (int r = 0; r < 16; ++r) al[r] = wsf[crow(r, hi)];
#pragma unroll
        for (int d0 = 0; d0 < 8; ++d0)
#pragma unroll
            for (int r = 0; r < 16; ++r) o[d0][r] *= al[r];
    }
    float ps = 0.f;
#pragma unroll
    for (int r = 0; r < 16; ++r) { p0[r] = __builtin_amdgcn_exp2f(p0[r] - m_reg); ps += p0[r]; }
#pragma unroll
    for (int r = 0; r < 16; ++r) { p1[r] = __builtin_amdgcn_exp2f(p1[r] - m_reg); ps += p1[r]; }
    l_reg += ps;
    bf16x8 pa0, pa1, pa2, pa3;
#define DA_PK4(P, B_, OUT) do { const unsigned a0 = cvtpk(P[B_ + 0], P[B_ + 1]), a1 = cvtpk(P[B_ + 2], P[B_ + 3]); \
        const unsigned b0 = cvtpk(P[B_ + 4], P[B_ + 5]), b1 = cvtpk(P[B_ + 6], P[B_ + 7]); \
        auto r0 = __builtin_amdgcn_permlane32_swap(a0, b0, false, false); auto r1 = __builtin_amdgcn_permlane32_swap(a1, b1, false, false); \
        u32x4 w = {r0[0], r1[0], r0[1], r1[1]}; OUT = __builtin_bit_cast(bf16x8, w); } while (0)
    DA_PK4(p0, 0, pa0); DA_PK4(p0, 8, pa1); DA_PK4(p1, 0, pa2); DA_PK4(p1, 8, pa3);
#undef DA_PK4
    const int vbs = vb + ST * STAGE;
#define DA_TRRD(dst, off) asm volatile("ds_read_b64_tr_b16 %0, %1 offset:%2" : "=&v"(dst) : "v"(vbs), "i"(off) : "memory")
#define DA_PV(d0) do { s16x4 l0, l1, l2, l3, h0, h1, h2, h3; constexpr int b_ = (d0) * 512; \
        DA_TRRD(l0, b_); DA_TRRD(h0, b_ + 4096); DA_TRRD(l1, b_ + 8192); DA_TRRD(h1, b_ + 12288); DA_TRRD(l2, b_ + 16384); DA_TRRD(h2, b_ + 20480); DA_TRRD(l3, b_ + 24576); DA_TRRD(h3, b_ + 28672); \
        asm volatile("s_waitcnt lgkmcnt(0)" ::: "memory"); DA_SBAR(); \
        o[d0] = __builtin_amdgcn_mfma_f32_32x32x16_bf16(pa0, (bf16x8){l0[0], l0[1], l0[2], l0[3], h0[0], h0[1], h0[2], h0[3]}, o[d0], 0, 0, 0); \
        o[d0] = __builtin_amdgcn_mfma_f32_32x32x16_bf16(pa1, (bf16x8){l1[0], l1[1], l1[2], l1[3], h1[0], h1[1], h1[2], h1[3]}, o[d0], 0, 0, 0); \
        o[d0] = __builtin_amdgcn_mfma_f32_32x32x16_bf16(pa2, (bf16x8){l2[0], l2[1], l2[2], l2[3], h2[0], h2[1], h2[2], h2[3]}, o[d0], 0, 0, 0); \
        o[d0] = __builtin_amdgcn_mfma_f32_32x32x16_bf16(pa3, (bf16x8){l3[0], l3[1], l3[2], l3[3], h3[0], h3[1], h3[2], h3[3]}, o[d0], 0, 0, 0); } while (0)
    DA_PV(0); DA_PV(1); DA_PV(2); DA_PV(3); DA_PV(4); DA_PV(5); DA_PV(6); DA_PV(7);
#undef DA_PV
#undef DA_TRRD
}

__device__ __forceinline__ void attn_unit(int h, int qb, const Tensors& T, float lam, DA_LAS unsigned char* lds, int wid) {
    const int lane = fresh_lane(), tid = wid * 64 + lane, r32 = lane & 31, hi = lane >> 5;
    const int rb = wid & 3, sh = wid >> 2;
    const int q0 = qb * 128, qw = q0 + rb * 32;
    const int NT = 2 * (qb + 1);
    const int ntw = (qw + 31) / 64 + 1;
    DA_LAS float* tbl = (DA_LAS float*)(lds + OFF_TBL);
    DA_LAS float* wsf = (DA_LAS float*)(lds + OFF_WS) + wid * 64;
    if (tid < 128) {
        const int n = tid; int bucket = n;
        if (n >= 16) { const float v = logf((float)n / 16.0f) / 2.0794415416798357f * 16.0f; const int lg = 16 + (int)v; bucket = lg < 31 ? lg : 31; }
        tbl[n] = (T.rel_bias[bucket * 16 + h] - T.rel_bias[31 * 16 + h]) * LOG2E;
    }
    const bool isK = wid < 4; const int wv = wid - 4;
    const unsigned laneK = (unsigned)((lane >> 4) * 8192 + (((lane & 15) ^ (lane >> 4)) << 4));
    const unsigned laneV = (unsigned)((8 * ((lane >> 4) & 1) + ((lane >> 2) & 3)) * 8192 + (lane >> 5) * 64 + (lane & 3) * 16);
    const unsigned laneoff = isK ? laneK : laneV;
    const bf16_t* gplane = isK ? T.K : T.V;
    const unsigned goff = (unsigned)h * 512u + (isK ? (unsigned)(wid >> 1) * 256u + (unsigned)((wid & 1) * 32) * 8192u : (unsigned)(16 * wv) * 8192u);
    const int dst0 = isK ? (wid >> 1) * 16384 + (wid & 1) * 8192 : OFF_V + wv * 8192;
#define DA_DMA(t_, st_) do { _Pragma("unroll") for (int i_ = 0; i_ < 8; ++i_) { \
        const unsigned uo_ = goff + (unsigned)(t_) * (64u * 8192u) + (isK ? (unsigned)(i_ * 32768) : (unsigned)((i_ >> 2) * 32768 + (i_ & 3) * 128)); \
        const unsigned lo_ = (laneoff ^ (isK ? (unsigned)((i_ & 3) << 6) : 0u)) + uo_; \
        const unsigned ld_ = (unsigned)(uintptr_t)lds + (unsigned)((st_) * STAGE + dst0 + i_ * 1024); unsigned keep_; \
        asm volatile("s_mov_b32 %0, m0\n\ts_mov_b32 m0, %3\n\ts_nop 0\n\tglobal_load_lds_dwordx4 %1, %2\n\ts_mov_b32 m0, %0" : "=&s"(keep_) : "v"(lo_), "s"(gplane), "s"(ld_) : "memory"); } } while (0)
    DA_DMA(0, 0);
    const bf16_t* Qw = T.Q + (size_t)(qw + r32) * PITCH + h * 256 + sh * 128 + hi * 8;
    bf16x8 qr[8];
#pragma unroll
    for (int d0 = 0; d0 < 8; ++d0) qr[d0] = *(const bf16x8*)(Qw + d0 * 16);
    const int kbase = sh * 16384 + r32 * 256 + (((r32 & 15) ^ hi) << 4);
    const int vb = (int)(uintptr_t)lds + OFF_V + v_rd_base(lane);
    float m_reg = -1e30f, l_reg = 0.f;
    f32x16 o[8];
#pragma unroll
    for (int d0 = 0; d0 < 8; ++d0) o[d0] = f32x16{};
    for (int t = 0; t < NT; t += 2) {
        DA_WAIT_BAR();
        DA_DMA(t + 1, 1);
        if (t < ntw) tile<0>(lds, t, qw, r32, hi, kbase, vb, qr, o, m_reg, l_reg, wsf, tbl);
        DA_WAIT_BAR();
        if (t + 2 < NT) DA_DMA(t + 2, 0);
        if (t + 1 < ntw) tile<1>(lds, t + 1, qw, r32, hi, kbase, vb, qr, o, m_reg, l_reg, wsf, tbl);
    }
#undef DA_DMA
    { auto rr = __builtin_amdgcn_permlane32_swap(__float_as_uint(l_reg), __float_as_uint(l_reg), false, false); l_reg = __uint_as_float(rr[0]) + __uint_as_float(rr[1]); }
    if (hi == 0) wsf[r32] = 1.0f / l_reg;
    asm volatile("s_waitcnt lgkmcnt(0)" ::: "memory");
    float rli[16];
#pragma unroll
    for (int r = 0; r < 16; ++r) rli[r] = wsf[crow(r, hi)];
#pragma unroll
    for (int d0 = 0; d0 < 8; ++d0)
#pragma unroll
        for (int r = 0; r < 16; ++r) o[d0][r] *= rli[r];
    DA_WAIT_BAR();
    DA_LAS f32x4* X4 = (DA_LAS f32x4*)(lds + rb * 32768);
    if (sh == 1) { const float nl = -lam;
#pragma unroll
        for (int d0 = 0; d0 < 8; ++d0) {
#pragma unroll
            for (int j = 0; j < 4; ++j) { f32x4 v; v[0] = o[d0][4 * j] * nl; v[1] = o[d0][4 * j + 1] * nl; v[2] = o[d0][4 * j + 2] * nl; v[3] = o[d0][4 * j + 3] * nl;
                X4[(d0 * 4 + j) * 64 + lane] = v; }
            DA_SBAR(); }
    }
    DA_WAIT_BAR();
    if (sh == 0) {
        u32x4 zq[16];
#pragma unroll
        for (int pass = 0; pass < 16; ++pass) zq[pass] = *(const u32x4*)(T.Z + (size_t)(qw + 2 * pass + hi) * PITCH + h * 256 + r32 * 8);
#pragma unroll
        for (int d0 = 0; d0 < 8; ++d0)
#pragma unroll
            for (int j = 0; j < 4; ++j) { const f32x4 v = X4[(d0 * 4 + j) * 64 + lane]; o[d0][4 * j] += v[0]; o[d0][4 * j + 1] += v[1]; o[d0][4 * j + 2] += v[2]; o[d0][4 * j + 3] += v[3]; if (j == 3) DA_SBAR(); }
        float rs[16];
#pragma unroll
        for (int r = 0; r < 16; ++r) { float s = 0.f;
#pragma unroll
            for (int d0 = 0; d0 < 8; ++d0) s += o[d0][r] * o[d0][r];
            s += swz_xor<1>(s); s += swz_xor<2>(s); s += swz_xor<4>(s); s += swz_xor<8>(s); s += swz_xor<16>(s);
            rs[r] = 0.8f * __builtin_amdgcn_rsqf(s * (1.0f / 256.0f) + 1e-5f); }
        float gn[8];
#pragma unroll
        for (int d0 = 0; d0 < 8; ++d0) gn[d0] = T.subln[d0 * 32 + r32];
        asm volatile("s_waitcnt lgkmcnt(0)" ::: "memory");
        DA_LAS float* Y = (DA_LAS float*)(lds + rb * 32768);
#pragma unroll
        for (int d0 = 0; d0 < 8; ++d0)
#pragma unroll
            for (int r = 0; r < 16; ++r) Y[crow(r, hi) * 256 + d0 * 32 + r32] = o[d0][r] * rs[r] * gn[d0];
        asm volatile("s_waitcnt lgkmcnt(0)" ::: "memory");
#pragma unroll
        for (int pass = 0; pass < 16; ++pass) { const int row = 2 * pass + hi;
            const DA_LAS f32x4* yp = (const DA_LAS f32x4*)(Y + row * 256 + r32 * 8); const f32x4 y0 = yp[0], y1 = yp[1];
            const size_t go = (size_t)(qw + row) * PITCH + h * 256 + r32 * 8;
            const u32x4 zz = zq[pass];
            u32x4 w;
            w.x = cvtpk(y0[0] * silu(__uint_as_float(zz.x << 16)), y0[1] * silu(__uint_as_float(zz.x & 0xffff0000u)));
            w.y = cvtpk(y0[2] * silu(__uint_as_float(zz.y << 16)), y0[3] * silu(__uint_as_float(zz.y & 0xffff0000u)));
            w.z = cvtpk(y1[0] * silu(__uint_as_float(zz.z << 16)), y1[1] * silu(__uint_as_float(zz.z & 0xffff0000u)));
            w.w = cvtpk(y1[2] * silu(__uint_as_float(zz.w << 16)), y1[3] * silu(__uint_as_float(zz.w & 0xffff0000u)));
            *(u32x4*)(T.O + go) = w; }
    }
    DA_WAIT_BAR();
}

__device__ __forceinline__ void attn_phase(DA_LAS unsigned char* lds, const Tensors& T, const float* lamp, int vcu, int G, int wid) {
    const int lane = fresh_lane();
    float s1 = lamp[lane] * lamp[128 + lane] + lamp[64 + lane] * lamp[192 + lane];
    float s2 = lamp[256 + lane] * lamp[384 + lane] + lamp[320 + lane] * lamp[448 + lane];
#pragma unroll
    for (int o_ = 1; o_ < 64; o_ <<= 1) { s1 += __shfl_xor(s1, o_); s2 += __shfl_xor(s2, o_); }
    const float lam = __int_as_float(__builtin_amdgcn_readfirstlane(__float_as_int(expf(s1) - expf(s2) + 0.2f)));
    const int nit = (G == 256) ? 4 : (vcu < 1024 ? (1024 - vcu + G - 1) / G : 0);
    for (int u = 0; u < 2 * nit; ++u) {
        const int i = u >> 1; int h, pi;
        if (G == 256) { h = 2 * (vcu >> 5) + (i >> 1); pi = (i & 1) * 32 + (vcu & 31); }
        else { const int p = vcu + i * G; h = p >> 6; pi = p & 63; }
        attn_unit(h, (u & 1) ? pi : 127 - pi, T, lam, lds, wid);
    }
}
#undef DA_WAIT_BAR
#undef DA_SBAR
}
#define GAS __attribute__((address_space(1)))
#define LAS __attribute__((address_space(3)))
typedef unsigned short bf16;
typedef unsigned v4u __attribute__((ext_vector_type(4)));
typedef float f32x4 __attribute__((ext_vector_type(4)));
typedef short bf16x8 __attribute__((ext_vector_type(8)));
typedef GAS unsigned gu32;
typedef GAS unsigned long long gu64;
#define RLX_AGENT __ATOMIC_RELAXED, __HIP_MEMORY_SCOPE_AGENT
#define LDS_WAIT() asm volatile("s_waitcnt lgkmcnt(0)" ::: "memory")
#define VM_WAIT() asm volatile("s_waitcnt vmcnt(0)" ::: "memory")
__device__ __forceinline__ unsigned long long rt() { return __builtin_amdgcn_s_memrealtime(); }
__device__ __forceinline__ unsigned f2bf(float f) { unsigned u = __builtin_bit_cast(unsigned, f); return (u + 0x7fffu + ((u >> 16) & 1u)) >> 16; }
__device__ __forceinline__ unsigned pk2(float lo, float hi) { unsigned r; asm("v_cvt_pk_bf16_f32 %0, %1, %2" : "=v"(r) : "v"(lo), "v"(hi)); return r; }

#define XB_TMO      128
#define XB_XCNT(j)  (256  + 64 * (j))
#define XB_XSUB(j)  (1280 + 64 * (j))
#define XB_XGEN(j)  (2304 + 64 * (j))
#define XB_TOP      3328
#define XB_TOPGEN   3392
#define XCD_BAR_WORDS 3456
#define XB_SPIN_CAP (1u << 18)

__device__ __forceinline__ unsigned xb_ld(unsigned* p)              { return __hip_atomic_load(p, __ATOMIC_RELAXED, __HIP_MEMORY_SCOPE_AGENT); }
__device__ __forceinline__ unsigned xb_add(unsigned* p, unsigned v) { return __hip_atomic_fetch_add(p, v, __ATOMIC_RELAXED, __HIP_MEMORY_SCOPE_AGENT); }
__device__ __forceinline__ unsigned xb_xcc_id() { return (unsigned)__builtin_amdgcn_s_getreg((3 << 11) | 20) & 0xFu; }
#define XB_SPIN(cond, bar) do { unsigned _sp = 0; while (cond) { __builtin_amdgcn_s_sleep(1); \
    if ((++_sp & 255u) == 0u) { if (xb_ld(&(bar)[XB_TMO])) break; if (_sp > XB_SPIN_CAP) { atomicAdd(&(bar)[XB_TMO], 1u); break; } } } } while (0)

struct XcdBarrier {
    unsigned* bar; unsigned x;
    volatile LAS unsigned* st;
};

__device__ __forceinline__ XcdBarrier xcd_barrier_post(unsigned* bar, volatile LAS unsigned* st) {
    XcdBarrier b; b.bar = bar; b.x = xb_xcc_id(); b.st = st;
    if (threadIdx.x == 0) (void)xb_add(&bar[XB_XCNT(b.x)], 1u);
    return b;
}
__device__ __forceinline__ void xcd_barrier_complete(unsigned* bar, unsigned x, unsigned& nloc, unsigned& nx) {
    const unsigned G = gridDim.x * gridDim.y * gridDim.z;
    unsigned sum, cnt, mine, sp = 0u;
    for (;;) {
        sum = 0u; cnt = 0u; mine = 0u;
#pragma unroll
        for (unsigned j = 0; j < 16; ++j) { const unsigned c = xb_ld(&bar[XB_XCNT(j)]); sum += c; cnt += (c > 0u) ? 1u : 0u; mine = (j == x) ? c : mine; }
        if (sum == G) break;
        __builtin_amdgcn_s_sleep(1);
        if ((++sp & 255u) == 0u) { if (xb_ld(&bar[XB_TMO])) break; if (sp > XB_SPIN_CAP) { atomicAdd(&bar[XB_TMO], 1u); break; } }
    }
    nloc = mine > 0u ? mine : 1u; nx = cnt > 0u ? cnt : 1u;
}

__device__ __forceinline__ void xcd_barrier(const XcdBarrier& b, const int wave_) {
    asm volatile("s_waitcnt vmcnt(0)" ::: "memory");
    __syncthreads();
    int lane_; asm volatile("v_mbcnt_lo_u32_b32 %0, -1, 0\n\tv_mbcnt_hi_u32_b32 %0, -1, %0" : "=v"(lane_));
    if (wave_ == 0 && lane_ == 0) {
        unsigned* bar = b.bar;
        __builtin_amdgcn_s_waitcnt(0);
        unsigned nloc = b.st[0], nx = b.st[1];
        if (nloc == 0u) { xcd_barrier_complete(bar, b.x, nloc, nx); b.st[0] = nloc; b.st[1] = nx; }
        const unsigned old = xb_add(&bar[XB_XSUB(b.x)], 1u);
        const unsigned gen = old / nloc;
        if (old + 1u == (gen + 1u) * nloc) {
            __builtin_amdgcn_fence(__ATOMIC_RELEASE, "agent");
            asm volatile("s_waitcnt vmcnt(0)" ::: "memory");
            const unsigned og = xb_add(&bar[XB_TOP], 1u);
            const unsigned tg = og / nx;
            if (og + 1u == (tg + 1u) * nx) xb_add(&bar[XB_TOPGEN], 1u);
            else XB_SPIN(xb_ld(&bar[XB_TOPGEN]) == tg, bar);
            __builtin_amdgcn_fence(__ATOMIC_ACQUIRE, "agent");
            xb_add(&bar[XB_XGEN(b.x)], 1u);
            asm volatile("s_waitcnt vmcnt(0)" ::: "memory");
        } else {
            XB_SPIN(xb_ld(&bar[XB_XGEN(b.x)]) == gen, bar);
            __builtin_amdgcn_fence(__ATOMIC_ACQUIRE, "agent");
            asm volatile("s_waitcnt vmcnt(0)" ::: "memory");
        }
    }
    __syncthreads();
}
constexpr int NWAVES = 8;
constexpr int SEQ = 16384, DM = 4096, NH = 16, AW = 4096, PW = 8192, PGD = 2048;
constexpr float NORM_EPS = 1e-6f;
#ifndef MK_N_LAUNCHES
#define MK_N_LAUNCHES 1
#endif
constexpr int N_PHASES = 9;

constexpr size_t MiB = 1u << 20;
constexpr size_t WS_CTL = 0, CTL_ZERO_BYTES = 256 * 1024;
constexpr size_t WS_SS1 = 64 * 1024, WS_SS2 = 128 * 1024;
constexpr size_t WS_SS0 = 256 * 1024;
constexpr size_t WS_WO1 = 2 * MiB, WS_WG = 34 * MiB, WS_WO2 = 66 * MiB, WS_W2 = 130 * MiB;
constexpr size_t WS_Q = 258 * MiB, WS_K = 386 * MiB, WS_V = 514 * MiB, WS_Z = 642 * MiB, WS_O = 770 * MiB;
constexpr size_t WS_YF = 386 * MiB, WS_YL = 418 * MiB;
constexpr size_t WS_Z2 = 642 * MiB;
constexpr size_t WS_WINU = 898 * MiB;
constexpr size_t WS_END = 962 * MiB;
constexpr size_t OUT_W1 = 0, OUT_XB = 128 * MiB;
constexpr int CW_TMO = 0, CW_BAR = 4096, CW_PANEL = 8192;

constexpr int RING_BYTES = 131072;
constexpr int LDS_BYTES = 163840;
constexpr int MISC_OFF = LDS_BYTES - 256;
static_assert(dattn::LDS_END <= MISC_OFF && 8 * 64 * 65 * 4 <= MISC_OFF, "LDS map");

__device__ __forceinline__ float wave_sum(float v) {
#pragma unroll
    for (int o = 1; o < 64; o <<= 1) v += __shfl_xor(v, o);
    return v;
}
__device__ __forceinline__ void transpose_item(const float* W, int N, int nblk, bf16* WT, int ldt, const float* gain, LAS float* scr, int item, int lane) {
    const int kb = item / nblk, nb = item - kb * nblk, k0 = kb * 64, n0 = nb * 64;
    const int lr = lane >> 4, lc = (lane & 15) * 4;
    f32x4 ld[16];
#pragma unroll
    for (int i = 0; i < 16; ++i) ld[i] = *(const f32x4*)(W + (size_t)(k0 + 4 * i + lr) * N + n0 + lc);
#pragma unroll
    for (int i = 0; i < 16; ++i) { const int kk = 4 * i + lr; f32x4 v = ld[i];
        if (gain) { const float g = gain[k0 + kk]; v = v * g; }
        LAS float* s = scr + kk * 65 + lc; s[0] = v[0]; s[1] = v[1]; s[2] = v[2]; s[3] = v[3]; }
    LDS_WAIT(); asm volatile("" ::: "memory");
    const int c = lane & 7;
#pragma unroll 2
    for (int j = 0; j < 8; ++j) { const int n = (lane >> 3) + 8 * j; const LAS float* s = scr + (8 * c) * 65 + n;
        v4u o; o.x = pk2(s[0 * 65], s[1 * 65]); o.y = pk2(s[2 * 65], s[3 * 65]); o.z = pk2(s[4 * 65], s[5 * 65]); o.w = pk2(s[6 * 65], s[7 * 65]);
        *(v4u*)(WT + (size_t)(n0 + n) * ldt + k0 + 8 * c) = o; }
    LDS_WAIT(); asm volatile("" ::: "memory");
}

__device__ __forceinline__ void unpack8(const v4u q, float (&f)[8]) {
    f[0] = __uint_as_float(q.x << 16); f[1] = __uint_as_float(q.x & 0xffff0000u); f[2] = __uint_as_float(q.y << 16); f[3] = __uint_as_float(q.y & 0xffff0000u);
    f[4] = __uint_as_float(q.z << 16); f[5] = __uint_as_float(q.z & 0xffff0000u); f[6] = __uint_as_float(q.w << 16); f[7] = __uint_as_float(q.w & 0xffff0000u); }
struct Args { const float* in[12]; float* out; unsigned char* ws; int ph_lo, ph_hi; };

__global__ void __launch_bounds__(NWAVES * 64, 2) hybrid_fwd(Args args) {
    extern __shared__ __attribute__((aligned(16))) unsigned char lds_raw[];
    LAS unsigned char* lds = (LAS unsigned char*)lds_raw;
    volatile LAS unsigned* MISC = (volatile LAS unsigned*)(lds + MISC_OFF);
    const int tid0 = threadIdx.x, wave = __builtin_amdgcn_readfirstlane(tid0 >> 6);
    const int G = gridDim.x; const int bx = blockIdx.x; const int vcu = (G % 8 == 0) ? (bx % 8) * (G / 8) + bx / 8 : bx;
    unsigned char* ws = args.ws; unsigned char* outb = (unsigned char*)args.out;
    const float* x = args.in[0]; const float* norm_gains = args.in[1]; const float* final_gain = args.in[2]; const float* rel_bias = args.in[3];
    const float* attn_w_in = args.in[4]; const float* attn_lambda = args.in[5]; const float* attn_subln = args.in[6]; const float* attn_w_out = args.in[7];
    const float* pool_w_in = args.in[8]; const float* pool_w_group = args.in[9]; const float* pool_scale = args.in[10]; const float* pool_w_out = args.in[11];
    unsigned* ctl = (unsigned*)(ws + WS_CTL);
    float* ss0 = (float*)(ws + WS_SS0); float* ss1 = (float*)(ws + WS_SS1); float* ss2 = (float*)(ws + WS_SS2);
    bf16* W1t = (bf16*)(outb + OUT_W1); bf16* XB = (bf16*)(outb + OUT_XB);
    bf16* Wo1t = (bf16*)(ws + WS_WO1); bf16* Wgt = (bf16*)(ws + WS_WG); bf16* Wo2t = (bf16*)(ws + WS_WO2); bf16* W2t = (bf16*)(ws + WS_W2);
    bf16* Qp = (bf16*)(ws + WS_Q); bf16* Kp = (bf16*)(ws + WS_K); bf16* Vp = (bf16*)(ws + WS_V); bf16* Zp = (bf16*)(ws + WS_Z); bf16* Op = (bf16*)(ws + WS_O);
    bf16* WinU = (bf16*)(ws + WS_WINU);
    bf16* XB1 = Qp; bf16* Z2p = (bf16*)(ws + WS_Z2);
    float* xres = args.out;

    if (tid0 < 64) ((LAS unsigned*)(lds + MISC_OFF))[tid0] = 0u;
    __syncthreads();
    XcdBarrier bar; bar.bar = ctl + CW_BAR; bar.x = 0; bar.st = nullptr;
    if (MK_N_LAUNCHES == 1) bar = xcd_barrier_post(ctl + CW_BAR, MISC);
    const int lo = args.ph_lo, hi = args.ph_hi;
#define IN(k) (lo <= (k) && (k) < hi)
#define GRID_BAR(k) do { if (IN((k) + 1)) xcd_barrier(bar, wave); } while (0)

    if (IN(0)) {
        const int lane = dattn::fresh_lane();
        LAS float* scr = (LAS float*)lds + wave * (64 * 65);
        const int gw = vcu * NWAVES + wave, NGW = G * NWAVES;
        constexpr int I_W1 = (DM / 64) * (4 * AW / 64), I_WO1 = (AW / 64) * (DM / 64), I_W2Z = (DM / 64) * (PW / 64), I_WG = (PGD / 64) * (PGD / 64), I_WO2 = (PW / 64) * (DM / 64);
        constexpr int NITEMS = I_W1 + I_WO1 + I_W2Z + 4 * I_WG + I_WO2;
        for (int it = gw; it < NITEMS; it += NGW) {
            int r = it;
            if (r < I_W1) { transpose_item(attn_w_in, 4 * AW, 4 * AW / 64, W1t, DM, norm_gains, scr, r, lane); continue; } r -= I_W1;
            if (r < I_WO1) { transpose_item(attn_w_out, DM, DM / 64, Wo1t, AW, nullptr, scr, r, lane); continue; } r -= I_WO1;
            if (r < I_W2Z) { const int n0 = (r % (PW / 64)) * 64;
                transpose_item(pool_w_in + PW, 2 * PW, PW / 64, W2t + (size_t)((n0 >> 7) * 128 + 128) * DM, DM, norm_gains + DM, scr, r, lane); continue; } r -= I_W2Z;
            if (r < 4 * I_WG) { const int g = r / I_WG; transpose_item(pool_w_group + (size_t)g * PGD * PGD, PGD, PGD / 64, Wgt + (size_t)g * PGD * PGD, PGD, nullptr, scr, r - g * I_WG, lane); continue; } r -= 4 * I_WG;
            transpose_item(pool_w_out, DM, DM / 64, Wo2t, PW, nullptr, scr, r, lane);
        }
        {
            const int gt0 = gw * 64 + lane, NT0 = NGW * 64;
            for (int i0 = gt0; i0 < DM * (PW / 8); i0 += 4 * NT0) {
                f32x4 a[4], b4[4];
#pragma unroll
                for (int u = 0; u < 4; ++u) { const int i = i0 + u * NT0; if (i < DM * (PW / 8)) { const int k = i >> 10, c8 = (i & 1023) * 8;
                    a[u] = *(const f32x4*)(pool_w_in + (size_t)k * (2 * PW) + c8); b4[u] = *(const f32x4*)(pool_w_in + (size_t)k * (2 * PW) + c8 + 4); } }
#pragma unroll
                for (int u = 0; u < 4; ++u) { const int i = i0 + u * NT0; if (i < DM * (PW / 8)) { const int k = i >> 10, c8 = (i & 1023) * 8; const float gk = norm_gains[DM + k];
                    v4u o; o.x = pk2(a[u][0] * gk, a[u][1] * gk); o.y = pk2(a[u][2] * gk, a[u][3] * gk); o.z = pk2(b4[u][0] * gk, b4[u][1] * gk); o.w = pk2(b4[u][2] * gk, b4[u][3] * gk);
                    *(v4u*)(WinU + (size_t)k * PW + c8) = o; } } }
        }
        for (int m = gw; m < SEQ; m += NGW) {
            const f32x4* xr = (const f32x4*)(x + (size_t)m * DM) + lane; unsigned long long* o8 = (unsigned long long*)(XB + (size_t)m * DM) + lane; float s = 0.f;
            f32x4 xv[16];
#pragma unroll
            for (int j = 0; j < 16; ++j) xv[j] = xr[64 * j];
#pragma unroll
            for (int j = 0; j < 16; ++j) { const f32x4 v = xv[j]; s += (v[0] * v[0] + v[1] * v[1]) + (v[2] * v[2] + v[3] * v[3]);
                o8[64 * j] = (unsigned long long)pk2(v[0], v[1]) | ((unsigned long long)pk2(v[2], v[3]) << 32); }
            s = wave_sum(s); if (lane == 0) ss0[m] = s;
        }
        GRID_BAR(0);
    }
    if (IN(1)) {
        pg8::Gemm g{Wgt, WinU, PW, DM, PGD, PGD, PW, -1, 0, 3, PGD * 2}; pg8::StaticOrder S; S.init(PW, DM, G, bx);
        pg8::EpiPlain E{W2t, DM, 1};
        pg8::gemm_phase<pg8::EpiPlain, pg8::StaticOrder, true, true>(lds, g, S, E, wave);
    }
    if (IN(2)) {
        pg8::Gemm g{XB, W1t, SEQ, 4 * AW, DM, DM, DM, -1, 0, -1, 0}; pg8::StaticOrder S; S.init(SEQ, 4 * AW, G, bx);
        pg8::EpiNormSplit E{Qp, ss0, AW, (size_t)(WS_K - WS_Q) / 2, dattn::QSCALE, NORM_EPS, -1, 1.0f};
        pg8::gemm_phase<pg8::EpiNormSplit, pg8::StaticOrder, true, true>(lds, g, S, E, wave);
        GRID_BAR(2);
    }
    if (IN(3)) {
        const dattn::Tensors T{Qp, Kp, Vp, Zp, Op, rel_bias, attn_subln};
        dattn::attn_phase(lds, T, attn_lambda, vcu, G, wave);
        GRID_BAR(3);
    }
    if (IN(4)) {
        pg8::Gemm g{Op, Wo1t, SEQ, DM, AW, AW, AW, -1, 0, -1, 0};
        pg8::EpiResid E{x, nullptr, nullptr, XB1, ss1, DM};
        { pg8::StaticOrder S; S.init(SEQ, DM, G, bx); pg8::gemm_phase<pg8::EpiResid, pg8::StaticOrder, true, true>(lds, g, S, E, wave); }
        GRID_BAR(4);
    }
    bf16* MZp = (bf16*)(ws + WS_Z2); bf16* Yf = (bf16*)(ws + WS_YF); bf16* Yl = (bf16*)(ws + WS_YL);
    if (IN(5)) {
        pg8::Gemm g{XB1, W2t, SEQ, 2 * PW, DM, DM, DM, -1, 0, -1, 0}; pg8::StaticOrder S; S.init(SEQ, 2 * PW, G, bx);
        pg8::EpiPool E{MZp, Yf, Yl, ss1, pool_scale, lds + RING_BYTES, NORM_EPS};
        pg8::gemm_phase<pg8::EpiPool, pg8::StaticOrder, true, true>(lds, g, S, E, wave);
        GRID_BAR(5);
    }
    if (IN(6)) {
        const int gt = vcu * (NWAVES * 64) + wave * 64 + dattn::fresh_lane(), NT_ = G * NWAVES * 64;
        for (int task = gt; task < (SEQ / 256) * (PW / 8); task += NT_) {
            const int cc = task & 1023, pm = __builtin_amdgcn_readfirstlane(task >> 10), w = 2 << __builtin_amdgcn_readfirstlane(cc >> 8);
            const bf16* yp = Yl + ((size_t)(pm - 1) * 16) * PW + (size_t)cc * 8; const bf16* yc = Yf + ((size_t)pm * 16) * PW + (size_t)cc * 8; bf16* mz = MZp + ((size_t)pm * 256) * PW + (size_t)cc * 8;
            const f32x4 sc0 = *(const f32x4*)(pool_scale + cc * 8), sc1 = *(const f32x4*)(pool_scale + cc * 8 + 4);
            float scv[8], s[8];
#pragma unroll
            for (int e = 0; e < 8; ++e) { scv[e] = (e < 4 ? sc0[e] : sc1[e - 4]) * 0.6931471805599453f; s[e] = 0.f; }
            for (int r = 16 - w + 1; r < 16; ++r) if (pm > 0) { float f[8]; unpack8(*(const v4u*)(yp + (size_t)r * PW), f);
#pragma unroll
                for (int e = 0; e < 8; ++e) s[e] += f[e]; }
            for (int r = 0; r < 16; ++r) {
                float u[8], o_[8], z[8], a[8]; unpack8(*(const v4u*)(yc + (size_t)r * PW), u); unpack8(*(const v4u*)(mz + (size_t)r * PW), z);
#pragma unroll
                for (int e = 0; e < 8; ++e) { s[e] += u[e]; o_[e] = 0.f; }
                const int cnt = (pm == 0 && r + 1 < w) ? r + 1 : w; const float ic = 1.0f / (float)cnt;
#pragma unroll
                for (int e = 0; e < 8; ++e) a[e] = (s[e] * ic - u[e]) * scv[e] * (z[e] * __builtin_amdgcn_rcpf(1.0f + __builtin_amdgcn_exp2f(-z[e])));
                v4u o; o.x = pk2(a[0], a[1]); o.y = pk2(a[2], a[3]); o.z = pk2(a[4], a[5]); o.w = pk2(a[6], a[7]);
                *(v4u*)(mz + (size_t)r * PW) = o;
                const int ro = r + 1 - w;
                if (ro >= 0) unpack8(*(const v4u*)(yc + (size_t)ro * PW), o_); else if (pm > 0) unpack8(*(const v4u*)(yp + (size_t)(16 + ro) * PW), o_);
#pragma unroll
                for (int e = 0; e < 8; ++e) s[e] -= o_[e];
            }
        }
        GRID_BAR(6);
    }
    const bool fused_tail = (MK_N_LAUNCHES == 1) && (G % (DM / 256) == 0);
    if (IN(7)) {
        pg8::Gemm g{Z2p, Wo2t, SEQ, DM, PW, PW, PW, -1, 0, -1, 0};
        if (fused_tail) {
            pg8::PanelOrder S; S.init(SEQ, DM, G, vcu);
            pg8::EpiFinal E{XB1, xres, ss2, ctl + CW_PANEL, ctl + CW_BAR + XB_TMO, final_gain, DM, NORM_EPS, (unsigned)(DM / 256)};
            pg8::gemm_phase<pg8::EpiFinal, pg8::PanelOrder, true, true>(lds, g, S, E, wave);
        } else {
            pg8::StaticOrder S; S.init(SEQ, DM, G, bx);
            pg8::EpiResid E{nullptr, XB1, xres, nullptr, ss2, DM};
            pg8::gemm_phase<pg8::EpiResid, pg8::StaticOrder, true, true>(lds, g, S, E, wave);
            GRID_BAR(7);
        }
    }
    if (IN(8) && !fused_tail) {
        const int gt = vcu * (NWAVES * 64) + wave * 64 + dattn::fresh_lane(), NT_ = G * NWAVES * 64;
        const bool bad = (MK_N_LAUNCHES == 1) && (__hip_atomic_load(ctl + CW_BAR + XB_TMO, __ATOMIC_RELAXED, __HIP_MEMORY_SCOPE_AGENT) != 0u);
        const float qnan = __builtin_nanf("");
        for (int i0 = gt; i0 < SEQ * (DM / 4); i0 += 8 * NT_) {
            f32x4 v[8]; float sq[8];
#pragma unroll
            for (int u = 0; u < 8; ++u) { const int i = i0 + u * NT_; if (i < SEQ * (DM / 4)) { v[u] = ((const f32x4*)xres)[i]; sq[u] = ss2[i >> 10]; } }
#pragma unroll
            for (int u = 0; u < 8; ++u) { const int i = i0 + u * NT_; if (i < SEQ * (DM / 4)) { const float rs = 1.0f / sqrtf(sq[u] * (1.0f / 4096.0f) + NORM_EPS);
                const f32x4 gg = ((const f32x4*)final_gain)[i & 1023]; f32x4 r = v[u] * rs * gg; if (bad) r = (f32x4){qnan, qnan, qnan, qnan};
                ((f32x4*)xres)[i] = r; } } }
    }
#undef IN
#undef GRID_BAR
}

extern "C" void kernel_launch(void* const* d_in, const int* in_sizes, int n_in, void* d_out, int out_size, void* d_ws, size_t ws_size, hipStream_t stream) {
    static int grid = 0;
    if (grid == 0) {
        if (n_in != 12 || in_sizes[0] != SEQ * DM || out_size != SEQ * DM || ws_size < WS_END) {
            fprintf(stderr, "kernel_launch: built for 12 inputs, x/out of %d floats, >= %zu bytes of workspace; got n_in %d, in0 %d, out %d, ws %zu; nothing launched\n", SEQ * DM, (size_t)WS_END, n_in, n_in > 0 ? in_sizes[0] : -1, out_size, ws_size); grid = -1; return; }
        int dev = 0, cus = 0, per_cu = 0;
        if (hipGetDevice(&dev) != hipSuccess || hipDeviceGetAttribute(&cus, hipDeviceAttributeMultiprocessorCount, dev) != hipSuccess) { fprintf(stderr, "kernel_launch: device query failed\n"); grid = -1; return; }
        if (hipFuncSetAttribute((const void*)hybrid_fwd, hipFuncAttributeMaxDynamicSharedMemorySize, LDS_BYTES) != hipSuccess) { fprintf(stderr, "kernel_launch: hipFuncSetAttribute failed\n"); grid = -1; return; }
        if (hipOccupancyMaxActiveBlocksPerMultiprocessor(&per_cu, (const void*)hybrid_fwd, NWAVES * 64, LDS_BYTES) != hipSuccess || per_cu < 1)
            fprintf(stderr, "kernel_launch: note: occupancy query reports %d workgroups per CU\n", per_cu);
        (void)hipGetLastError();
        grid = cus;
    }
    if (grid < 0) return;
    if (hipMemsetAsync((char*)d_ws + WS_CTL, 0, CTL_ZERO_BYTES, stream) != hipSuccess) { fprintf(stderr, "kernel_launch: hipMemsetAsync failed\n"); return; }
    Args a{};
    for (int i = 0; i < 12; ++i) a.in[i] = (const float*)d_in[i];
    a.out = (float*)d_out; a.ws = (unsigned char*)d_ws;
    for (int li = 0; li < MK_N_LAUNCHES; ++li) {
        a.ph_lo = (MK_N_LAUNCHES == 1) ? 0 : li; a.ph_hi = (MK_N_LAUNCHES == 1) ? N_PHASES : li + 1;
        hipLaunchKernelGGL(hybrid_fwd, dim3(grid), dim3(NWAVES * 64), LDS_BYTES, stream, a);
        const hipError_t le = hipPeekAtLastError();
        if (le != hipSuccess) { fprintf(stderr, "kernel_launch: launch %d failed: %s\n", li, hipGetErrorName(le)); break; }
    }
}
```

```cpp
#include <hip/hip_runtime.h>
#include <cstdio>
#include <cstdint>
#include <cmath>
namespace pg8 {
#define PG8_LAS __attribute__((address_space(3)))
typedef unsigned short bf16_t;
typedef short bf16x8 __attribute__((ext_vector_type(8)));
typedef float f32x4 __attribute__((ext_vector_type(4)));
typedef unsigned u32x4 __attribute__((ext_vector_type(4)));
typedef unsigned u32x2 __attribute__((ext_vector_type(2)));
constexpr int BM = 256, BK = 64, HALF = 128, HTB = HALF * BK * 2  , STAGE_BYTES = 8 * HTB, NXCD = 8, WGM = 4;

__host__ __device__ __forceinline__ int lds_byte(int r, int c) { const int st = (r >> 4) * 2 + (c >> 5), rr = r & 15, cc = c & 31, ob = rr * 64 + cc * 2; return st * 1024 + (ob ^ (((ob >> 9) & 1) << 5)); }
__host__ __device__ __forceinline__ void stage_rc(int b, int& R, int& C) { const int st = b / 1024, sb = b % 1024, swz = sb ^ (((sb >> 9) & 1) << 5); R = (st >> 1) * 16 + swz / 64; C = (st & 1) * 32 + (swz % 64) / 2; }
__host__ __device__ __forceinline__ int perm32(int rho) { const int n = rho >> 4, i = rho & 15; return 8 * (i >> 2) + 4 * n + (i & 3); }

struct Unit { int pm, pn; };
struct Gemm { const bf16_t* A; const bf16_t* Bt; int M, N, K, lda, ldb, gshift, gstride, bshift, bstride;
    __device__ __forceinline__ size_t aoff(int pn) const { return gshift >= 0 ? (size_t)(pn >> gshift) * (size_t)gstride : (size_t)0; }
    __device__ __forceinline__ size_t boff(int pm) const { return bshift >= 0 ? (size_t)(pm >> bshift) * (size_t)bstride : (size_t)0; } };

struct StaticOrder {
    int nM, nN, nwg, G, c;
    __host__ __device__ void init(int M, int N, int G_, int c_) { nM = M / BM; nN = N / BM; nwg = nM * nN; G = G_; c = c_; }
    __host__ __device__ bool next(int i, Unit& u) const {
        const long L = (long)i * G + c; if (L >= nwg) return false;
        int wgid = (int)L; { const int q = nwg / NXCD, r = nwg % NXCD, xcd = wgid % NXCD, off = wgid / NXCD; wgid = (xcd < r ? xcd * (q + 1) : r * (q + 1) + (xcd - r) * q) + off; }
        const int nig = WGM * nN, gid = wgid / nig, fm = gid * WGM, gsz = (nM - fm) < WGM ? (nM - fm) : WGM;
        u.pm = fm + ((wgid % nig) % gsz); u.pn = (wgid % nig) / gsz; return true;
    }
    __device__ __forceinline__ void a_ready(const Unit&) const {}
    __device__ __forceinline__ void done(const Unit&) const {}
};

struct PanelOrder {
    int nN, nwg, G, c;
    __host__ __device__ void init(int M, int N, int G_, int c_) { nN = N / BM; nwg = (M / BM) * nN; G = G_; c = c_; }
    __host__ __device__ bool next(int i, Unit& u) const {
        const long L0 = (long)i * G; if (L0 + c >= nwg) return false;
        if (nN % 16 == 0 && G % 64 == 0 && nwg % G == 0 && ((nwg / nN) % (G / 16)) == 0) {
            const int ncs = nN / 16, rg = i / ncs, sc = i - rg * ncs;
            const int q = c >> 6, h = (c >> 5) & 1, j = c & 31;
            u.pm = rg * (G / 16) + q * 4 + (j & 3); u.pn = sc * 16 + h * 8 + (j >> 2); return true; }
        const long L = L0 + c; u.pm = (int)(L / nN); u.pn = (int)(L % nN); return true;
    }
    __device__ __forceinline__ void a_ready(const Unit&) const {}
    __device__ __forceinline__ void done(const Unit&) const {}
};

__device__ __forceinline__ unsigned cvt_pk_bf16(float lo, float hi) { unsigned r; asm volatile("v_cvt_pk_bf16_f32 %0, %1, %2" : "=v"(r) : "v"(lo), "v"(hi)); return r; }
typedef float f32x2 __attribute__((ext_vector_type(2)));
template <class Epi, class Sched, bool ALIGN_EPI = false, bool SP2 = false>
__device__ __forceinline__ void gemm_phase(PG8_LAS unsigned char* lds, const Gemm g, const Sched& S, const Epi& E, const int wid) {
    int lane; asm volatile("v_mbcnt_lo_u32_b32 %0, -1, 0\n\tv_mbcnt_hi_u32_b32 %0, -1, %0" : "=v"(lane));
    const int tid = wid * 64 + lane, wr = wid >> 2, wc = wid & 3, fr = lane & 15, fq = lane >> 4;
    const int K = g.K, nt = K / BK;
    unsigned voffA[2], voffB[2];
#pragma unroll
    for (int i = 0; i < 2; ++i) { int R, C; stage_rc(tid * 16 + i * 8192, R, C); const int Rb = Epi::PERM ? ((R & ~31) + perm32(R & 31)) : R;
        voffA[i] = (unsigned)(R * g.lda + C) * 2u; voffB[i] = (unsigned)(Rb * g.ldb + C) * 2u; }
    const size_t kstep = (size_t)(BK * 2);
    const size_t hstepA = (size_t)HALF * g.lda * 2, hstepB = (size_t)HALF * g.ldb * 2;
    const size_t tstepA = 2 * hstepA, tstepB = 2 * hstepB;
    const unsigned ldsw = (unsigned)wid * 1024u;
    const int aoff = lds_byte(wr * 64 + fr, fq * 8), boff = lds_byte(wc * 32 + fr, fq * 8);
#define PG8_SA(b, h) (((b) * 2 + (h)) * HTB)
#define PG8_SB(b, h) ((4 + (b) * 2 + (h)) * HTB)
#define PG8_STAGE(bufoff, gbase, voff) do { _Pragma("unroll") for (int _i = 0; _i < 2; ++_i) \
        __builtin_amdgcn_global_load_lds((const unsigned*)((const char*)(gbase) + (voff)[_i]), (PG8_LAS unsigned*)(lds + (bufoff) + ldsw + _i * 8192), 16, 0, 0); } while (0)
#define PG8_LDA(dst, b, h) do { _Pragma("unroll") for (int m = 0; m < 4; ++m) _Pragma("unroll") for (int k = 0; k < 2; ++k) dst[m][k] = *(const PG8_LAS bf16x8*)(lds + PG8_SA(b, h) + aoff + m * 2048 + k * 1024); } while (0)
#define PG8_LDB(dst, b, h) do { _Pragma("unroll") for (int n = 0; n < 2; ++n) _Pragma("unroll") for (int k = 0; k < 2; ++k) dst[n][k] = *(const PG8_LAS bf16x8*)(lds + PG8_SB(b, h) + boff + n * 2048 + k * 1024); } while (0)
#define PG8_MMA(ai, bj, At, Bt) do { __builtin_amdgcn_s_setprio(1); _Pragma("unroll") for (int m = 0; m < 4; ++m) _Pragma("unroll") for (int n = 0; n < 2; ++n) _Pragma("unroll") for (int k = 0; k < 2; ++k) \
        acc[ai][bj][m][n] = (Epi::YNT && (bj) == 0) ? __builtin_amdgcn_mfma_f32_16x16x32_bf16(At[m][k], Bt[n][k], acc[ai][bj][m][n], 0, 0, 0) : __builtin_amdgcn_mfma_f32_16x16x32_bf16(Bt[n][k], At[m][k], acc[ai][bj][m][n], 0, 0, 0); __builtin_amdgcn_s_setprio(0); } while (0)
#define PG8_WAIT_V(n) asm volatile("s_waitcnt vmcnt(" #n ")" ::: "memory")
#define PG8_WAIT_L(n) asm volatile("s_waitcnt lgkmcnt(" #n ")" ::: "memory")
#define PG8_BAR __builtin_amdgcn_s_barrier()
#define PG8_SCHED __builtin_amdgcn_sched_barrier(0)
    Unit cur, nxt; int ui = 0;
    if (!S.next(0, cur)) return;
    f32x4 acc[2][2][4][2];
#pragma unroll
    for (int a = 0; a < 2; ++a)
#pragma unroll
        for (int b = 0; b < 2; ++b)
#pragma unroll
            for (int m = 0; m < 4; ++m)
#pragma unroll
                for (int n = 0; n < 2; ++n) acc[a][b][m][n] = (f32x4){0.f, 0.f, 0.f, 0.f};
    bf16x8 At[4][2], B0[2][2], B1[2][2];
    const char* cA = (const char*)g.A + (size_t)cur.pm * tstepA + g.aoff(cur.pn); const char* cB = (const char*)g.Bt + (size_t)cur.pn * tstepB + g.boff(cur.pm);
    S.a_ready(cur);
    if constexpr (SP2) {
        PG8_STAGE(PG8_SB(0, 0), cB, voffB); PG8_STAGE(PG8_SB(0, 1), cB + hstepB, voffB); PG8_STAGE(PG8_SA(0, 0), cA, voffA); PG8_STAGE(PG8_SA(0, 1), cA + hstepA, voffA);
        if (wr == 1) PG8_BAR;
        PG8_WAIT_V(2); PG8_BAR;
        PG8_STAGE(PG8_SB(1, 0), cB + kstep, voffB); PG8_STAGE(PG8_SA(1, 0), cA + kstep, voffA); PG8_STAGE(PG8_SB(1, 1), cB + hstepB + kstep, voffB);
        PG8_WAIT_V(6); PG8_BAR;
    } else {
        PG8_STAGE(PG8_SB(0, 0), cB, voffB); PG8_STAGE(PG8_SA(0, 0), cA, voffA); PG8_STAGE(PG8_SB(0, 1), cB + hstepB, voffB); PG8_STAGE(PG8_SA(0, 1), cA + hstepA, voffA);
        if (wr == 1) PG8_BAR;
        PG8_WAIT_V(4); PG8_BAR;
        PG8_STAGE(PG8_SB(1, 0), cB + kstep, voffB); PG8_STAGE(PG8_SA(1, 0), cA + kstep, voffA); PG8_STAGE(PG8_SB(1, 1), cB + hstepB + kstep, voffB);
        PG8_WAIT_V(6); PG8_BAR;
    }
    for (;;) {
        const bool has_next = S.next(ui + 1, nxt);
        const char* nA = has_next ? (const char*)g.A + (size_t)nxt.pm * tstepA + g.aoff(nxt.pn) : cA; const char* nB = has_next ? (const char*)g.Bt + (size_t)nxt.pn * tstepB + g.boff(nxt.pm) : cB;
        for (int t = 0; t < nt; t += 2) {
            const bool last = (t == nt - 2);
            const char* a1 = cA + (size_t)(t + 1) * kstep;
            const char* a2 = last ? nA : cA + (size_t)(t + 2) * kstep; const char* b2 = last ? nB : cB + (size_t)(t + 2) * kstep;
            const char* a3 = a2 + kstep; const char* b3 = b2 + kstep;
            if (last && has_next) S.a_ready(nxt);
            if constexpr (SP2) {
            PG8_LDB(B0, 0, 0); PG8_LDB(B1, 0, 1); PG8_SCHED; PG8_LDA(At, 0, 0); PG8_STAGE(PG8_SA(1, 1), a1 + hstepA, voffA);
            PG8_WAIT_V(8); PG8_WAIT_L(0); PG8_BAR; PG8_MMA(0, 0, At, B0); PG8_MMA(0, 1, At, B1); PG8_BAR; PG8_SCHED;
            PG8_LDA(At, 0, 1); PG8_STAGE(PG8_SB(0, 0), b2, voffB); PG8_STAGE(PG8_SB(0, 1), b2 + hstepB, voffB); PG8_STAGE(PG8_SA(0, 0), a2, voffA);
            PG8_WAIT_V(8); PG8_WAIT_L(0); PG8_BAR; PG8_MMA(1, 0, At, B0); PG8_MMA(1, 1, At, B1); PG8_BAR; PG8_SCHED;
            PG8_LDB(B0, 1, 0); PG8_LDB(B1, 1, 1); PG8_SCHED; PG8_LDA(At, 1, 0); PG8_STAGE(PG8_SA(0, 1), a2 + hstepA, voffA);
            PG8_WAIT_V(8); PG8_WAIT_L(0); PG8_BAR; PG8_MMA(0, 0, At, B0); PG8_MMA(0, 1, At, B1); PG8_BAR; PG8_SCHED;
            PG8_LDA(At, 1, 1); PG8_STAGE(PG8_SB(1, 0), b3, voffB); PG8_STAGE(PG8_SB(1, 1), b3 + hstepB, voffB); PG8_STAGE(PG8_SA(1, 0), a3, voffA);
            PG8_WAIT_V(8); PG8_WAIT_L(0); PG8_BAR; PG8_MMA(1, 0, At, B0); PG8_MMA(1, 1, At, B1); PG8_BAR; PG8_SCHED;
            } else {
            PG8_LDB(B0, 0, 0); PG8_SCHED; PG8_LDA(At, 0, 0); PG8_STAGE(PG8_SA(1, 1), a1 + hstepA, voffA);
            PG8_WAIT_L(8); PG8_BAR; PG8_WAIT_L(0); PG8_MMA(0, 0, At, B0); PG8_BAR; PG8_SCHED;
            PG8_LDB(B1, 0, 1); PG8_STAGE(PG8_SB(0, 0), b2, voffB);
            PG8_BAR; PG8_WAIT_L(0); PG8_MMA(0, 1, At, B1); PG8_BAR;
            PG8_LDA(At, 0, 1); PG8_STAGE(PG8_SA(0, 0), a2, voffA);
            PG8_BAR; PG8_WAIT_L(0); PG8_MMA(1, 0, At, B0); PG8_BAR; PG8_SCHED;
            PG8_STAGE(PG8_SB(0, 1), b2 + hstepB, voffB);
            PG8_WAIT_V(6); PG8_BAR; PG8_MMA(1, 1, At, B1); PG8_BAR;
            PG8_LDB(B0, 1, 0); PG8_SCHED; PG8_LDA(At, 1, 0); PG8_STAGE(PG8_SA(0, 1), a2 + hstepA, voffA);
            PG8_WAIT_L(8); PG8_BAR; PG8_WAIT_L(0); PG8_MMA(0, 0, At, B0); PG8_BAR; PG8_SCHED;
            PG8_LDB(B1, 1, 1); PG8_STAGE(PG8_SB(1, 0), b3, voffB);
            PG8_BAR; PG8_WAIT_L(0); PG8_MMA(0, 1, At, B1); PG8_BAR;
            PG8_LDA(At, 1, 1); PG8_STAGE(PG8_SA(1, 0), a3, voffA);
            PG8_BAR; PG8_WAIT_L(0); PG8_MMA(1, 0, At, B0); PG8_BAR; PG8_SCHED;
            PG8_STAGE(PG8_SB(1, 1), b3 + hstepB, voffB);
            PG8_WAIT_V(6); PG8_BAR; PG8_MMA(1, 1, At, B1); PG8_BAR;
            }
        }
        if constexpr (ALIGN_EPI) { if (wr == 0) PG8_BAR; }
        if constexpr (!Epi::AFTER_DRAIN) { E(acc, cur, wr, wc, fr, fq); S.done(cur); }
        if (!has_next) break;
#pragma unroll
        for (int a = 0; a < 2; ++a)
#pragma unroll
            for (int b = 0; b < 2; ++b)
#pragma unroll
                for (int m = 0; m < 4; ++m)
#pragma unroll
                    for (int n = 0; n < 2; ++n) acc[a][b][m][n] = (f32x4){0.f, 0.f, 0.f, 0.f};
        cur = nxt; cA = nA; cB = nB; ++ui;
        if constexpr (ALIGN_EPI) { if (wr == 1) PG8_BAR; }
    }
    PG8_WAIT_V(0);
    if constexpr (!ALIGN_EPI) { if (wr == 0) PG8_BAR; }
    PG8_BAR;
    if constexpr (Epi::AFTER_DRAIN) { E.fused(acc, cur, wr, wc, fr, fq, lds, wid, lane); S.done(cur); }
#undef PG8_SA
#undef PG8_SB
#undef PG8_STAGE
#undef PG8_LDA
#undef PG8_LDB
#undef PG8_MMA
#undef PG8_WAIT_V
#undef PG8_WAIT_L
#undef PG8_BAR
#undef PG8_SCHED
}
}
namespace pg8 {
__device__ __forceinline__ u32x4 pack8_bf16(const f32x4 v0, const f32x4 v1) { u32x4 w; w.x = cvt_pk_bf16(v0[0], v0[1]); w.y = cvt_pk_bf16(v0[2], v0[3]); w.z = cvt_pk_bf16(v1[0], v1[1]); w.w = cvt_pk_bf16(v1[2], v1[3]); return w; }

struct EpiNormSplit {
    static constexpr bool PERM = true, AFTER_DRAIN = false, YNT = false;
    bf16_t* O; const float* ss; int split_cols; size_t split_stride; float scale0; float eps; int zplane; float scalez;
    __device__ __forceinline__ void operator()(const f32x4 (&acc)[2][2][4][2], const Unit& u, int wr, int wc, int fr, int fq) const {
        const int row0 = u.pm * BM + wr * 64 + fr; int colt = u.pn * BM; bf16_t* base = O;
        const int t = colt / split_cols; base += (size_t)t * split_stride; colt -= t * split_cols;
        const float sc = (t == 0) ? scale0 : ((t == zplane) ? scalez : 1.f);
        const int col0 = colt + wc * 32 + 8 * fq;
        float ssv[2][4];
#pragma unroll
        for (int ai = 0; ai < 2; ++ai)
#pragma unroll
            for (int m = 0; m < 4; ++m) ssv[ai][m] = ss[row0 + ai * HALF + m * 16];
#pragma unroll
        for (int ai = 0; ai < 2; ++ai)
#pragma unroll
            for (int m = 0; m < 4; ++m) { const int row = row0 + ai * HALF + m * 16;
                const float rs = sc * __builtin_amdgcn_rsqf(ssv[ai][m] * (1.0f / 4096.0f) + eps);
                bf16_t* rowp = base + (size_t)row * split_cols + col0;
#pragma unroll
                for (int bj = 0; bj < 2; ++bj) { const f32x4 v0 = acc[ai][bj][m][0] * rs, v1 = acc[ai][bj][m][1] * rs; *(u32x4*)(rowp + bj * HALF) = pack8_bf16(v0, v1); } }
    }
};

struct EpiPlain {
    static constexpr bool PERM = true, AFTER_DRAIN = false, YNT = false;
    bf16_t* O; int ldc; int ymap;
    __device__ __forceinline__ void operator()(const f32x4 (&acc)[2][2][4][2], const Unit& u, int wr, int wc, int fr, int fq) const {
        const int row0 = u.pm * BM + wr * 64 + fr, col0 = u.pn * BM + wc * 32 + 8 * fq;
#pragma unroll
        for (int ai = 0; ai < 2; ++ai)
#pragma unroll
            for (int m = 0; m < 4; ++m) { int row = row0 + ai * HALF + m * 16; if (ymap) row = ((row >> 7) << 8) + (row & 127);
                bf16_t* rowp = O + (size_t)row * ldc + col0;
#pragma unroll
                for (int bj = 0; bj < 2; ++bj) *(u32x4*)(rowp + bj * HALF) = pack8_bf16(acc[ai][bj][m][0], acc[ai][bj][m][1]); }
    }
};

template <bool F32BASE, bool WOUT, bool WXB>
struct EpiResid {
    static constexpr bool PERM = true, AFTER_DRAIN = false, YNT = false;
    const float* base; const bf16_t* baseh; float* out; bf16_t* xb; float* ss; int ldc;
    __device__ __forceinline__ void operator()(const f32x4 (&acc)[2][2][4][2], const Unit& u, int wr, int wc, int fr, int fq) const {
        const int row0 = u.pm * BM + wr * 64 + fr, col0 = u.pn * BM + wc * 32 + 8 * fq;
#pragma unroll
        for (int ai = 0; ai < 2; ++ai) {
            f32x4 bf[F32BASE ? 4 : 1][2][2]; u32x4 bh[F32BASE ? 1 : 4][2];
#pragma unroll
            for (int m = 0; m < 4; ++m)
#pragma unroll
                for (int bj = 0; bj < 2; ++bj) { const size_t off = (size_t)(row0 + ai * HALF + m * 16) * ldc + col0 + bj * HALF;
                    if constexpr (F32BASE) { bf[m][bj][0] = *(const f32x4*)(base + off); bf[m][bj][1] = *(const f32x4*)(base + off + 4); }
                    else bh[m][bj] = *(const u32x4*)(baseh + off); }
#pragma unroll
            for (int m = 0; m < 4; ++m) { const int row = row0 + ai * HALF + m * 16; const size_t off = (size_t)row * ldc + col0; float sq = 0.f;
#pragma unroll
                for (int bj = 0; bj < 2; ++bj) { f32x4 b0, b1;
                    if constexpr (F32BASE) { b0 = bf[m][bj][0]; b1 = bf[m][bj][1]; }
                    else { const u32x4 hq = bh[m][bj];
                        b0[0] = __uint_as_float(hq.x << 16); b0[1] = __uint_as_float(hq.x & 0xffff0000u); b0[2] = __uint_as_float(hq.y << 16); b0[3] = __uint_as_float(hq.y & 0xffff0000u);
                        b1[0] = __uint_as_float(hq.z << 16); b1[1] = __uint_as_float(hq.z & 0xffff0000u); b1[2] = __uint_as_float(hq.w << 16); b1[3] = __uint_as_float(hq.w & 0xffff0000u); }
                    const f32x4 v0 = acc[ai][bj][m][0] + b0, v1 = acc[ai][bj][m][1] + b1;
                    if constexpr (WOUT) { *(f32x4*)(out + off + bj * HALF) = v0; *(f32x4*)(out + off + bj * HALF + 4) = v1; }
                    sq += (v0[0] * v0[0] + v0[1] * v0[1]) + (v0[2] * v0[2] + v0[3] * v0[3]) + (v1[0] * v1[0] + v1[1] * v1[1]) + (v1[2] * v1[2] + v1[3] * v1[3]);
                    if constexpr (WXB) *(u32x4*)(xb + off + bj * HALF) = pack8_bf16(v0, v1); }
                sq += __shfl_xor(sq, 16); sq += __shfl_xor(sq, 32);
                if (fq == 0) unsafeAtomicAdd(ss + row, sq); }
        }
    }
};

struct EpiPool {
    static constexpr bool PERM = true, AFTER_DRAIN = false, YNT = true;
    bf16_t* MZ; bf16_t* Yf; bf16_t* Yl; const float* ss; const float* pscale; PG8_LAS unsigned char* xl; float eps;
    __device__ __forceinline__ void operator()(const f32x4 (&acc)[2][2][4][2], const Unit& u, int wr, int wc, int fr, int fq) const {
        constexpr int LDC = 8192;
        const int wid = wr * 4 + wc, lane = fq * 16 + fr;
        const int w = 2 << (u.pn >> 4);
        const int rowb = u.pm * BM + wr * 64, colb = u.pn * HALF + wc * 32 + 8 * fq;
        PG8_LAS float* RS = (PG8_LAS float*)xl + wid * 128;
        PG8_LAS u32x2* HALO = (PG8_LAS u32x2*)(xl + 4096);
        float rst[2][4];
#pragma unroll
        for (int ai = 0; ai < 2; ++ai)
#pragma unroll
            for (int m = 0; m < 4; ++m) rst[ai][m] = ss[rowb + ai * HALF + m * 16 + fr];
        const f32x4 ps0 = *(const f32x4*)(pscale + colb) * 0.6931471805599453f, ps1 = *(const f32x4*)(pscale + colb + 4) * 0.6931471805599453f;
#pragma unroll
        for (int ai = 0; ai < 2; ++ai)
#pragma unroll
            for (int m = 0; m < 4; ++m) { rst[ai][m] = __builtin_amdgcn_rsqf(rst[ai][m] * (1.0f / 4096.0f) + eps); if (fq == 0) RS[(ai * 4 + m) * 16 + fr] = rst[ai][m]; }
        asm volatile("s_waitcnt lgkmcnt(0)" ::: "memory");
        u32x2 ypk[2][4][2];
#pragma unroll
        for (int ai = 0; ai < 2; ++ai)
#pragma unroll
            for (int m = 0; m < 4; ++m) { const f32x4 rn = *(const PG8_LAS f32x4*)(RS + (ai * 4 + m) * 16 + 4 * fq);
#pragma unroll
                for (int n = 0; n < 2; ++n) { const f32x4 v = acc[ai][0][m][n] * rn; ypk[ai][m][n].x = cvt_pk_bf16(v[0], v[1]); ypk[ai][m][n].y = cvt_pk_bf16(v[2], v[3]); } }
#pragma unroll
        for (int n = 0; n < 2; ++n) {
            if (wr == 0) { HALO[((0 * 4 + wc) * 2 + n) * 64 + lane] = ypk[0][3][n]; HALO[((2 * 4 + wc) * 2 + n) * 64 + lane] = ypk[1][3][n]; }
            else HALO[((1 * 4 + wc) * 2 + n) * 64 + lane] = ypk[0][3][n]; }
        asm volatile("s_waitcnt lgkmcnt(0)" ::: "memory");
        __syncthreads();
        u32x2 hal[2][2];
#pragma unroll
        for (int n = 0; n < 2; ++n) {
            hal[0][n] = (u32x2){0u, 0u}; if (wr == 1) hal[0][n] = HALO[((0 * 4 + wc) * 2 + n) * 64 + lane];
            hal[1][n] = HALO[(((wr == 0 ? 1 : 2) * 4 + wc) * 2 + n) * 64 + lane]; }
        const float invw = 1.0f / (float)w;
        float cp[4], cc[4], ci[4];
#pragma unroll
        for (int e = 0; e < 4; ++e) { const int p = 4 * fq + e, dp = fr + 16 - p, dc = fr - p;
            cp[e] = (dp < w) ? invw : 0.f; cc[e] = (dc == 0) ? invw - 1.0f : ((dc > 0 && dc < w) ? invw : 0.f); ci[e] = (dc == 0) ? 1.0f : 0.f; }
        u32x4 bpw, biw; bpw.x = cvt_pk_bf16(cp[0], cp[1]); bpw.y = cvt_pk_bf16(cp[2], cp[3]); bpw.z = cvt_pk_bf16(cc[0], cc[1]); bpw.w = cvt_pk_bf16(cc[2], cc[3]);
        biw.x = 0u; biw.y = 0u; biw.z = cvt_pk_bf16(ci[0], ci[1]); biw.w = cvt_pk_bf16(ci[2], ci[3]);
        const bf16x8 bp = __builtin_bit_cast(bf16x8, bpw), bi = __builtin_bit_cast(bf16x8, biw);
        const f32x4 zero4 = (f32x4){0.f, 0.f, 0.f, 0.f};
        float zf; asm volatile("v_mov_b32 %0, 0" : "=v"(zf));
#pragma unroll
        for (int ai = 0; ai < 2; ++ai)
#pragma unroll
            for (int m = 0; m < 4; ++m) {
                const int row = rowb + ai * HALF + m * 16 + fr; bf16_t* dst = MZ + (size_t)row * LDC + colb;
                const float zs = rst[ai][m] * 1.4426950408889634f;
                f32x4 z0 = acc[ai][1][m][0] * zs, z1 = acc[ai][1][m][1] * zs;
                const bool first = (ai == 0 && m == 0) && (wr == 0), lastb = (ai == 1 && m == 3) && (wr == 1);
                if (first || lastb) {
                    u32x4 a0, a1; a0.x = 0u; a0.y = 0u; a0.z = ypk[ai][m][0].x; a0.w = ypk[ai][m][0].y; a1.x = 0u; a1.y = 0u; a1.z = ypk[ai][m][1].x; a1.w = ypk[ai][m][1].y;
                    const f32x4 y0 = __builtin_amdgcn_mfma_f32_16x16x32_bf16(__builtin_bit_cast(bf16x8, a0), bi, zero4, 0, 0, 0), y1 = __builtin_amdgcn_mfma_f32_16x16x32_bf16(__builtin_bit_cast(bf16x8, a1), bi, zero4, 0, 0, 0);
                    bf16_t* yd = (first ? Yf : Yl) + ((size_t)u.pm * 16 + fr) * LDC + colb;
                    *(u32x4*)yd = pack8_bf16(y0 + zf, y1 + zf); }
                if (first) { *(u32x4*)dst = pack8_bf16(z0, z1); }
                else {
                    const u32x2 pv0 = (m > 0) ? ypk[ai][m > 0 ? m - 1 : 0][0] : hal[ai][0], pv1 = (m > 0) ? ypk[ai][m > 0 ? m - 1 : 0][1] : hal[ai][1];
                    u32x4 a0, a1; a0.x = pv0.x; a0.y = pv0.y; a0.z = ypk[ai][m][0].x; a0.w = ypk[ai][m][0].y; a1.x = pv1.x; a1.y = pv1.y; a1.z = ypk[ai][m][1].x; a1.w = ypk[ai][m][1].y;
                    f32x4 d0 = __builtin_amdgcn_mfma_f32_16x16x32_bf16(__builtin_bit_cast(bf16x8, a0), bp, zero4, 0, 0, 0), d1 = __builtin_amdgcn_mfma_f32_16x16x32_bf16(__builtin_bit_cast(bf16x8, a1), bp, zero4, 0, 0, 0);
#pragma unroll
                    for (int e = 0; e < 4; ++e) { d0[e] *= ps0[e] * (z0[e] * __builtin_amdgcn_rcpf(1.0f + __builtin_amdgcn_exp2f(-z0[e]))); d1[e] *= ps1[e] * (z1[e] * __builtin_amdgcn_rcpf(1.0f + __builtin_amdgcn_exp2f(-z1[e]))); }
                    *(u32x4*)dst = pack8_bf16(d0, d1); }
            }
    }
};

struct EpiFinal {
    static constexpr bool PERM = true, AFTER_DRAIN = false, YNT = false;
    const bf16_t* baseh; float* out; float* ss; unsigned* cnt; unsigned* tmo; const float* gain; int ldc; float eps; unsigned nown;
    __device__ __forceinline__ void unpk(const u32x4 hq, f32x4& b0, f32x4& b1) const {
        b0[0] = __uint_as_float(hq.x << 16); b0[1] = __uint_as_float(hq.x & 0xffff0000u); b0[2] = __uint_as_float(hq.y << 16); b0[3] = __uint_as_float(hq.y & 0xffff0000u);
        b1[0] = __uint_as_float(hq.z << 16); b1[1] = __uint_as_float(hq.z & 0xffff0000u); b1[2] = __uint_as_float(hq.w << 16); b1[3] = __uint_as_float(hq.w & 0xffff0000u); }
    __device__ __forceinline__ void operator()(const f32x4 (&acc)[2][2][4][2], const Unit& u, int wr, int wc, int fr, int fq) const {
        const int row0 = u.pm * BM + wr * 64 + fr, col0 = u.pn * BM + wc * 32 + 8 * fq;
        u32x4 bh[2][4][2];
#pragma unroll
        for (int ai = 0; ai < 2; ++ai)
#pragma unroll
            for (int m = 0; m < 4; ++m)
#pragma unroll
                for (int bj = 0; bj < 2; ++bj) bh[ai][m][bj] = *(const u32x4*)(baseh + (size_t)(row0 + ai * HALF + m * 16) * ldc + col0 + bj * HALF);
        f32x4 gg[2][2];
#pragma unroll
        for (int bj = 0; bj < 2; ++bj)
#pragma unroll
            for (int n = 0; n < 2; ++n) gg[bj][n] = *(const f32x4*)(gain + col0 + bj * HALF + 4 * n);
#pragma unroll
        for (int ai = 0; ai < 2; ++ai)
#pragma unroll
            for (int m = 0; m < 4; ++m) { const int row = row0 + ai * HALF + m * 16; float sq = 0.f;
#pragma unroll
                for (int bj = 0; bj < 2; ++bj) { f32x4 b0, b1; unpk(bh[ai][m][bj], b0, b1);
                    const f32x4 v0 = acc[ai][bj][m][0] + b0, v1 = acc[ai][bj][m][1] + b1;
                    sq += (v0[0] * v0[0] + v0[1] * v0[1]) + (v0[2] * v0[2] + v0[3] * v0[3]) + (v1[0] * v1[0] + v1[1] * v1[1]) + (v1[2] * v1[2] + v1[3] * v1[3]); }
                sq += __shfl_xor(sq, 16); sq += __shfl_xor(sq, 32);
                if (fq == 0) unsafeAtomicAdd(ss + row, sq); }
        asm volatile("s_waitcnt vmcnt(0)" ::: "memory");
        __syncthreads();
        if (wr == 0 && wc == 0 && fr == 0 && fq == 0) {
            unsigned* c = cnt + u.pm;
            (void)__hip_atomic_fetch_add(c, 1u, __ATOMIC_RELAXED, __HIP_MEMORY_SCOPE_AGENT);
            unsigned sp = 0u;
            while (__hip_atomic_load(c, __ATOMIC_RELAXED, __HIP_MEMORY_SCOPE_AGENT) < nown) { __builtin_amdgcn_s_sleep(1);
                if ((++sp & 255u) == 0u) { if (__hip_atomic_load(tmo, __ATOMIC_RELAXED, __HIP_MEMORY_SCOPE_AGENT)) break; if (sp > (1u << 18)) { atomicAdd(tmo, 1u); break; } } }
        }
        __syncthreads();
        const bool bad = __hip_atomic_load(tmo, __ATOMIC_RELAXED, __HIP_MEMORY_SCOPE_AGENT) != 0u;
        const float qnan = __builtin_nanf("");
        float ssv[2][4];
#pragma unroll
        for (int ai = 0; ai < 2; ++ai)
#pragma unroll
            for (int m = 0; m < 4; ++m) ssv[ai][m] = __hip_atomic_load(ss + row0 + ai * HALF + m * 16, __ATOMIC_RELAXED, __HIP_MEMORY_SCOPE_AGENT);
#pragma unroll
        for (int ai = 0; ai < 2; ++ai)
#pragma unroll
            for (int m = 0; m < 4; ++m) { const int row = row0 + ai * HALF + m * 16; const size_t off = (size_t)row * ldc + col0;
                const float rs = bad ? qnan : __builtin_amdgcn_rsqf(ssv[ai][m] * (1.0f / 4096.0f) + eps);
#pragma unroll
                for (int bj = 0; bj < 2; ++bj) { f32x4 b0, b1; unpk(bh[ai][m][bj], b0, b1);
                    const f32x4 v0 = (acc[ai][bj][m][0] + b0) * rs * gg[bj][0], v1 = (acc[ai][bj][m][1] + b1) * rs * gg[bj][1];
                    *(f32x4*)(out + off + bj * HALF) = v0; *(f32x4*)(out + off + bj * HALF + 4) = v1; } }
    }
};
}
namespace dattn {
#define DA_LAS __attribute__((address_space(3)))
typedef unsigned short bf16_t;
typedef short bf16x8 __attribute__((ext_vector_type(8)));
typedef short s16x4 __attribute__((ext_vector_type(4)));
typedef float f32x16 __attribute__((ext_vector_type(16)));
typedef float f32x4 __attribute__((ext_vector_type(4)));
typedef unsigned u32x4 __attribute__((ext_vector_type(4)));
constexpr int PITCH = 4096;
constexpr int STAGE = 65536, OFF_V = 32768;
constexpr int OFF_TBL = 131072, OFF_WS = OFF_TBL + 512, LDS_END = OFF_WS + 8 * 256;
constexpr float LOG2E = 1.4426950408889634f;
constexpr float THR = 8.0f;
constexpr float QSCALE = 0.08838834764831845f * LOG2E;

__device__ __forceinline__ int crow(int r, int hi) { return (r & 3) + 8 * (r >> 2) + 4 * hi; }
__device__ __forceinline__ unsigned cvtpk(float lo, float hi) { unsigned r; asm volatile("v_cvt_pk_bf16_f32 %0, %1, %2" : "=v"(r) : "v"(lo), "v"(hi)); return r; }
__device__ __forceinline__ int v_rd_base(int lane) { return ((lane & 3) << 3) | (((lane >> 2) & 3) << 6) | (((lane >> 4) & 1) << 5) | (((lane >> 5) & 1) << 8); }
__device__ __forceinline__ float silu(float z) { return z * __builtin_amdgcn_rcpf(1.0f + __builtin_amdgcn_exp2f(-LOG2E * z)); }

__device__ __forceinline__ int fresh_lane() { int l; asm volatile("v_mbcnt_lo_u32_b32 %0, -1, 0\n\tv_mbcnt_hi_u32_b32 %0, -1, %0" : "=v"(l)); return l; }
template <int M> __device__ __forceinline__ float swz_xor(float v) { return __int_as_float(__builtin_amdgcn_ds_swizzle(__float_as_int(v), (M << 10) | 0x1f)); }
struct Tensors { const bf16_t* Q; const bf16_t* K; const bf16_t* V; const bf16_t* Z; bf16_t* O; const float* rel_bias; const float* subln; };

#define DA_WAIT_BAR() asm volatile("s_waitcnt vmcnt(0) lgkmcnt(0)\n\ts_barrier" ::: "memory")
#define DA_SBAR() __builtin_amdgcn_sched_barrier(0)

template <int ST>
__device__ __forceinline__ void tile(DA_LAS unsigned char* lds, int tt, int qw, int r32, int hi, int kbase, int vb, const bf16x8 (&qr)[8], f32x16 (&o)[8], float& m_reg, float& l_reg,
                                     DA_LAS float* wsf, const DA_LAS float* tbl) {
    const int k0 = tt * 64;
    asm volatile("" : "+v"(kbase), "+v"(vb));
    f32x16 p0 = {}, p1 = {};
#pragma unroll
    for (int d0 = 0; d0 < 8; ++d0) { const int a = ST * STAGE + (kbase ^ (d0 << 5));
        const bf16x8 b0 = *(const DA_LAS bf16x8*)(lds + a), b1 = *(const DA_LAS bf16x8*)(lds + a + 8192);
        p0 = __builtin_amdgcn_mfma_f32_32x32x16_bf16(b0, qr[d0], p0, 0, 0, 0);
        p1 = __builtin_amdgcn_mfma_f32_32x32x16_bf16(b1, qr[d0], p1, 0, 0, 0); }
    if (k0 + 176 > qw) {
        const float NEG = -__builtin_inff(); const int dq = qw + r32 - k0 - 4 * hi;
#pragma unroll
        for (int r = 0; r < 16; ++r) { const int c = (r & 3) + 8 * (r >> 2); const int d_0 = dq - c, d_1 = d_0 - 32;
            const int i0 = d_0 < 0 ? 0 : (d_0 > 127 ? 127 : d_0), i1 = d_1 < 0 ? 0 : (d_1 > 127 ? 127 : d_1);
            const float b_0 = tbl[i0], b_1 = tbl[i1];
            p0[r] = d_0 < 0 ? NEG : p0[r] + b_0; p1[r] = d_1 < 0 ? NEG : p1[r] + b_1; }
    }
#define DA_MX3(a, b, c) __builtin_fmaxf(__builtin_fmaxf((a), (b)), (c))
    float pmA = DA_MX3(p0[0], p0[1], p0[2]), pmB = DA_MX3(p0[3], p0[4], p0[5]), pmC = DA_MX3(p1[0], p1[1], p1[2]), pmD = DA_MX3(p1[3], p1[4], p1[5]);
#pragma unroll
    for (int r = 6; r < 14; r += 4) { pmA = DA_MX3(pmA, p0[r], p0[r + 1]); pmB = DA_MX3(pmB, p0[r + 2], p0[r + 3]); pmC = DA_MX3(pmC, p1[r], p1[r + 1]); pmD = DA_MX3(pmD, p1[r + 2], p1[r + 3]); }
    pmA = DA_MX3(pmA, p0[14], p0[15]); pmC = DA_MX3(pmC, p1[14], p1[15]);
    float pmax = fmaxf(DA_MX3(pmA, pmB, pmC), pmD);
#undef DA_MX3
    { auto rr = __builtin_amdgcn_permlane32_swap(__float_as_uint(pmax), __float_as_uint(pmax), false, false); pmax = fmaxf(__uint_as_float(rr[0]), __uint_as_float(rr[1])); }
    if (!__all(pmax - m_reg <= THR)) {
        const float mn = fmaxf(m_reg, pmax); const float alpha = __builtin_amdgcn_exp2f(m_reg - mn); m_reg = mn; l_reg *= alpha;
        if (hi == 0) wsf[r32] = alpha;
        asm volatile("s_waitcnt lgkmcnt(0)" ::: "memory");
        float al[16];
#pragma unroll
        for (int r = 0; r < 16; ++r) al[r] = wsf[crow(r, hi)];
#pragma unroll
        for (int d0 = 0; d0 < 8; ++d0)
#pragma unroll
            for (int r = 0; r < 16; ++r) o[d0][r] *= al[r];
    }
    float ps = 0.f;
#pragma unroll
    for (int r = 0; r < 16; ++r) { p0[r] = __builtin_amdgcn_exp2f(p0[r] - m_reg); ps += p0[r]; }
#pragma unroll
    for (int r = 0; r < 16; ++r) { p1[r] = __builtin_amdgcn_exp2f(p1[r] - m_reg); ps += p1[r]; }
    l_reg += ps;
    bf16x8 pa0, pa1, pa2, pa3;
#define DA_PK4(P, B_, OUT) do { const unsigned a0 = cvtpk(P[B_ + 0], P[B_ + 1]), a1 = cvtpk(P[B_ + 2], P[B_ + 3]); \
        const unsigned b0 = cvtpk(P[B_ + 4], P[B_ + 5]), b1 = cvtpk(P[B_ + 6], P[B_ + 7]); \
        auto r0 = __builtin_amdgcn_permlane32_swap(a0, b0, false, false); auto r1 = __builtin_amdgcn_permlane32_swap(a1, b1, false, false); \
        u32x4 w = {r0[0], r1[0], r0[1], r1[1]}; OUT = __builtin_bit_cast(bf16x8, w); } while (0)
    DA_PK4(p0, 0, pa0); DA_PK4(p0, 8, pa1); DA_PK4(p1, 0, pa2); DA_PK4(p1, 8, pa3);
#undef DA_PK4
    const int vbs = vb + ST * STAGE;
#define DA_TRRD(dst, off) asm volatile("ds_read_b64_tr_b16 %0, %1 offset:%2" : "=&v"(dst) : "v"(vbs), "i"(off) : "memory")
#define DA_PV(d0) do { s16x4 l0, l1, l2, l3, h0, h1, h2, h3; constexpr int b_ = (d0) * 512; \
        DA_TRRD(l0, b_); DA_TRRD(h0, b_ + 4096); DA_TRRD(l1, b_ + 8192); DA_TRRD(h1, b_ + 12288); DA_TRRD(l2, b_ + 16384); DA_TRRD(h2, b_ + 20480); DA_TRRD(l3, b_ + 24576); DA_TRRD(h3, b_ + 28672); \
        asm volatile("s_waitcnt lgkmcnt(0)" ::: "memory"); DA_SBAR(); \
        o[d0] = __builtin_amdgcn_mfma_f32_32x32x16_bf16(pa0, (bf16x8){l0[0], l0[1], l0[2], l0[3], h0[0], h0[1], h0[2], h0[3]}, o[d0], 0, 0, 0); \
        o[d0] = __builtin_amdgcn_mfma_f32_32x32x16_bf16(pa1, (bf16x8){l1[0], l1[1], l1[2], l1[3], h1[0], h1[1], h1[2], h1[3]}, o[d0], 0, 0, 0); \
        o[d0] = __builtin_amdgcn_mfma_f32_32x32x16_bf16(pa2, (bf16x8){l2[0], l2[1], l2[2], l2[3], h2[0], h2[1], h2[2], h2[3]}, o[d0], 0, 0, 0); \
        o[d0] = __builtin_amdgcn_mfma_f32_32x32x16_bf16(pa3, (bf16x8){l3[0], l3[1], l3[2], l3[3], h3[0], h3[1], h3[2], h3[3]}, o[d0], 0, 0, 0); } while (0)
    DA_PV(0); DA_PV(1); DA_PV(2); DA_PV(3); DA_PV(4); DA_PV(5); DA_PV(6); DA_PV(7);
#undef DA_PV
#undef DA_TRRD
}

__device__ __forceinline__ void attn_unit(int h, int qb, const Tensors& T, float lam, DA_LAS unsigned char* lds, int wid) {
    const int lane = fresh_lane(), tid = wid * 64 + lane, r32 = lane & 31, hi = lane >> 5;
    const int rb = wid & 3, sh = wid >> 2;
    const int q0 = qb * 128, qw = q0 + rb * 32;
    const int NT = 2 * (qb + 1);
    const int ntw = (qw + 31) / 64 + 1;
    DA_LAS float* tbl = (DA_LAS float*)(lds + OFF_TBL);
    DA_LAS float* wsf = (DA_LAS float*)(lds + OFF_WS) + wid * 64;
    if (tid < 128) {
        const int n = tid; int bucket = n;
        if (n >= 16) { const float v = logf((float)n / 16.0f) / 2.0794415416798357f * 16.0f; const int lg = 16 + (int)v; bucket = lg < 31 ? lg : 31; }
        tbl[n] = (T.rel_bias[bucket * 16 + h] - T.rel_bias[31 * 16 + h]) * LOG2E;
    }
    const bool isK = wid < 4; const int wv = wid - 4;
    const unsigned laneK = (unsigned)((lane >> 4) * 8192 + (((lane & 15) ^ (lane >> 4)) << 4));
    const unsigned laneV = (unsigned)((8 * ((lane >> 4) & 1) + ((lane >> 2) & 3)) * 8192 + (lane >> 5) * 64 + (lane & 3) * 16);
    const unsigned laneoff = isK ? laneK : laneV;
    const bf16_t* gplane = isK ? T.K : T.V;
    const unsigned goff = (unsigned)h * 512u + (isK ? (unsigned)(wid >> 1) * 256u + (unsigned)((wid & 1) * 32) * 8192u : (unsigned)(16 * wv) * 8192u);
    const int dst0 = isK ? (wid >> 1) * 16384 + (wid & 1) * 8192 : OFF_V + wv * 8192;
#define DA_DMA(t_, st_) do { _Pragma("unroll") for (int i_ = 0; i_ < 8; ++i_) { \
        const unsigned uo_ = goff + (unsigned)(t_) * (64u * 8192u) + (isK ? (unsigned)(i_ * 32768) : (unsigned)((i_ >> 2) * 32768 + (i_ & 3) * 128)); \
        const unsigned lo_ = (laneoff ^ (isK ? (unsigned)((i_ & 3) << 6) : 0u)) + uo_; \
        const unsigned ld_ = (unsigned)(uintptr_t)lds + (unsigned)((st_) * STAGE + dst0 + i_ * 1024); unsigned keep_; \
        asm volatile("s_mov_b32 %0, m0\n\ts_mov_b32 m0, %3\n\ts_nop 0\n\tglobal_load_lds_dwordx4 %1, %2\n\ts_mov_b32 m0, %0" : "=&s"(keep_) : "v"(lo_), "s"(gplane), "s"(ld_) : "memory"); } } while (0)
    DA_DMA(0, 0);
    const bf16_t* Qw = T.Q + (size_t)(qw + r32) * PITCH + h * 256 + sh * 128 + hi * 8;
    bf16x8 qr[8];
#pragma unroll
    for (int d0 = 0; d0 < 8; ++d0) qr[d0] = *(const bf16x8*)(Qw + d0 * 16);
    const int kbase = sh * 16384 + r32 * 256 + (((r32 & 15) ^ hi) << 4);
    const int vb = (int)(uintptr_t)lds + OFF_V + v_rd_base(lane);
    float m_reg = -1e30f, l_reg = 0.f;
    f32x16 o[8];
#pragma unroll
    for (int d0 = 0; d0 < 8; ++d0) o[d0] = f32x16{};
    for (int t = 0; t < NT; t += 2) {
        DA_WAIT_BAR();
        DA_DMA(t + 1, 1);
        if (t < ntw) tile<0>(lds, t, qw, r32, hi, kbase, vb, qr, o, m_reg, l_reg, wsf, tbl);
        DA_WAIT_BAR();
        if (t + 2 < NT) DA_DMA(t + 2, 0);
        if (t + 1 < ntw) tile<1>(lds, t + 1, qw, r32, hi, kbase, vb, qr, o, m_reg, l_reg, wsf, tbl);
    }
#undef DA_DMA
    { auto rr = __builtin_amdgcn_permlane32_swap(__float_as_uint(l_reg), __float_as_uint(l_reg), false, false); l_reg = __uint_as_float(rr[0]) + __uint_as_float(rr[1]); }
    if (hi == 0) wsf[r32] = 1.0f / l_reg;
    asm volatile("s_waitcnt lgkmcnt(0)" ::: "memory");
    float rli[16];
#pragma unroll
    for (int r = 0; r < 16; ++r) rli[r] = wsf[crow(r, hi)];
#pragma unroll
    for (int d0 = 0; d0 < 8; ++d0)
#pragma unroll
        for (int r = 0; r < 16; ++r) o[d0][r] *= rli[r];
    DA_WAIT_BAR();
    DA_LAS f32x4* X4 = (DA_LAS f32x4*)(lds + rb * 32768);
    if (sh == 1) { const float nl = -lam;
#pragma unroll
        for (int d0 = 0; d0 < 8; ++d0) {
#pragma unroll
            for (int j = 0; j < 4; ++j) { f32x4 v; v[0] = o[d0][4 * j] * nl; v[1] = o[d0][4 * j + 1] * nl; v[2] = o[d0][4 * j + 2] * nl; v[3] = o[d0][4 * j + 3] * nl;
                X4[(d0 * 4 + j) * 64 + lane] = v; }
            DA_SBAR(); }
    }
    DA_WAIT_BAR();
    if (sh == 0) {
        u32x4 zq[16];
#pragma unroll
        for (int pass = 0; pass < 16; ++pass) zq[pass] = *(const u32x4*)(T.Z + (size_t)(qw + 2 * pass + hi) * PITCH + h * 256 + r32 * 8);
#pragma unroll
        for (int d0 = 0; d0 < 8; ++d0)
#pragma unroll
            for (int j = 0; j < 4; ++j) { const f32x4 v = X4[(d0 * 4 + j) * 64 + lane]; o[d0][4 * j] += v[0]; o[d0][4 * j + 1] += v[1]; o[d0][4 * j + 2] += v[2]; o[d0][4 * j + 3] += v[3]; if (j == 3) DA_SBAR(); }
        float rs[16];
#pragma unroll
        for (int r = 0; r < 16; ++r) { float s = 0.f;
#pragma unroll
            for (int d0 = 0; d0 < 8; ++d0) s += o[d0][r] * o[d0][r];
            s += swz_xor<1>(s); s += swz_xor<2>(s); s += swz_xor<4>(s); s += swz_xor<8>(s); s += swz_xor<16>(s);
            rs[r] = 0.8f * __builtin_amdgcn_rsqf(s * (1.0f / 256.0f) + 1e-5f); }
        float gn[8];
#pragma unroll
        for (int d0 = 0; d0 < 8; ++d0) gn[d0] = T.subln[d0 * 32 + r32];
        asm volatile("s_waitcnt lgkmcnt(0)" ::: "memory");
        DA_LAS float* Y = (DA_LAS float*)(lds + rb * 32768);
#pragma unroll
        for (int d0 = 0; d0 < 8; ++d0)
#pragma unroll
            for (int r = 0; r < 16; ++r) Y[crow(r, hi) * 256 + d0 * 32 + r32] = o[d0][r] * rs[r] * gn[d0];
        asm volatile("s_waitcnt lgkmcnt(0)" ::: "memory");
#pragma unroll
        for (int pass = 0; pass < 16; ++pass) { const int row = 2 * pass + hi;
            const DA_LAS f32x4* yp = (const DA_LAS f32x4*)(Y + row * 256 + r32 * 8); const f32x4 y0 = yp[0], y1 = yp[1];
            const size_t go = (size_t)(qw + row) * PITCH + h * 256 + r32 * 8;
            const u32x4 zz = zq[pass];
            u32x4 w;
            w.x = cvtpk(y0[0] * silu(__uint_as_float(zz.x << 16)), y0[1] * silu(__uint_as_float(zz.x & 0xffff0000u)));
            w.y = cvtpk(y0[2] * silu(__uint_as_float(zz.y << 16)), y0[3] * silu(__uint_as_float(zz.y & 0xffff0000u)));
            w.z = cvtpk(y1[0] * silu(__uint_as_float(zz.z << 16)), y1[1] * silu(__uint_as_float(zz.z & 0xffff0000u)));
            w.w = cvtpk(y1[2] * silu(__uint_as_float(zz.w << 16)), y1[3] * silu(__uint_as_float(zz.w & 0xffff0000u)));
            *(u32x4*)(T.O + go) = w; }
    }
    DA_WAIT_BAR();
}

__device__ __forceinline__ void attn_phase(DA_LAS unsigned char* lds, const Tensors& T, const float* lamp, int vcu, int G, int wid) {
    const int lane = fresh_lane();
    float s1 = lamp[lane] * lamp[128 + lane] + lamp[64 + lane] * lamp[192 + lane];
    float s2 = lamp[256 + lane] * lamp[384 + lane] + lamp[320 + lane] * lamp[448 + lane];
#pragma unroll
    for (int o_ = 1; o_ < 64; o_ <<= 1) { s1 += __shfl_xor(s1, o_); s2 += __shfl_xor(s2, o_); }
    const float lam = __int_as_float(__builtin_amdgcn_readfirstlane(__float_as_int(expf(s1) - expf(s2) + 0.2f)));
    const int nit = (G == 256) ? 4 : (vcu < 1024 ? (1024 - vcu + G - 1) / G : 0);
    for (int u = 0; u < 2 * nit; ++u) {
        const int i = u >> 1; int h, pi;
        if (G == 256) { h = 2 * (vcu >> 5) + (i >> 1); pi = (i & 1) * 32 + (vcu & 31); }
        else { const int p = vcu + i * G; h = p >> 6; pi = p & 63; }
        attn_unit(h, (u & 1) ? pi : 127 - pi, T, lam, lds, wid);
    }
}
#undef DA_WAIT_BAR
#undef DA_SBAR
}
#define GAS __attribute__((address_space(1)))
#define LAS __attribute__((address_space(3)))
typedef unsigned short bf16;
typedef unsigned v4u __attribute__((ext_vector_type(4)));
typedef float f32x4 __attribute__((ext_vector_type(4)));
typedef short bf16x8 __attribute__((ext_vector_type(8)));
typedef GAS unsigned gu32;
typedef GAS unsigned long long gu64;
#define RLX_AGENT __ATOMIC_RELAXED, __HIP_MEMORY_SCOPE_AGENT
#define LDS_WAIT() asm volatile("s_waitcnt lgkmcnt(0)" ::: "memory")
#define VM_WAIT() asm volatile("s_waitcnt vmcnt(0)" ::: "memory")
__device__ __forceinline__ unsigned long long rt() { return __builtin_amdgcn_s_memrealtime(); }
__device__ __forceinline__ unsigned f2bf(float f) { unsigned u = __builtin_bit_cast(unsigned, f); return (u + 0x7fffu + ((u >> 16) & 1u)) >> 16; }
__device__ __forceinline__ unsigned pk2(float lo, float hi) { unsigned r; asm("v_cvt_pk_bf16_f32 %0, %1, %2" : "=v"(r) : "v"(lo), "v"(hi)); return r; }

#define XB_TMO      128
#define XB_XCNT(j)  (256  + 64 * (j))
#define XB_XSUB(j)  (1280 + 64 * (j))
#define XB_XGEN(j)  (2304 + 64 * (j))
#define XB_TOP      3328
#define XB_TOPGEN   3392
#define XCD_BAR_WORDS 3456
#define XB_SPIN_CAP (1u << 18)

__device__ __forceinline__ unsigned xb_ld(unsigned* p)              { return __hip_atomic_load(p, __ATOMIC_RELAXED, __HIP_MEMORY_SCOPE_AGENT); }
__device__ __forceinline__ unsigned xb_add(unsigned* p, unsigned v) { return __hip_atomic_fetch_add(p, v, __ATOMIC_RELAXED, __HIP_MEMORY_SCOPE_AGENT); }
__device__ __forceinline__ unsigned xb_xcc_id() { return (unsigned)__builtin_amdgcn_s_getreg((3 << 11) | 20) & 0xFu; }
#define XB_SPIN(cond, bar) do { unsigned _sp = 0; while (cond) { __builtin_amdgcn_s_sleep(1); \
    if ((++_sp & 255u) == 0u) { if (xb_ld(&(bar)[XB_TMO])) break; if (_sp > XB_SPIN_CAP) { atomicAdd(&(bar)[XB_TMO], 1u); break; } } } } while (0)

struct XcdBarrier {
    unsigned* bar; unsigned x;
    volatile LAS unsigned* st;
};

__device__ __forceinline__ XcdBarrier xcd_barrier_post(unsigned* bar, volatile LAS unsigned* st) {
    XcdBarrier b; b.bar = bar; b.x = xb_xcc_id(); b.st = st;
    if (threadIdx.x == 0) (void)xb_add(&bar[XB_XCNT(b.x)], 1u);
    return b;
}
__device__ __forceinline__ void xcd_barrier_complete(unsigned* bar, unsigned x, unsigned& nloc, unsigned& nx) {
    const unsigned G = gridDim.x * gridDim.y * gridDim.z;
    unsigned sum, cnt, mine, sp = 0u;
    for (;;) {
        sum = 0u; cnt = 0u; mine = 0u;
#pragma unroll
        for (unsigned j = 0; j < 16; ++j) { const unsigned c = xb_ld(&bar[XB_XCNT(j)]); sum += c; cnt += (c > 0u) ? 1u : 0u; mine = (j == x) ? c : mine; }
        if (sum == G) break;
        __builtin_amdgcn_s_sleep(1);
        if ((++sp & 255u) == 0u) { if (xb_ld(&bar[XB_TMO])) break; if (sp > XB_SPIN_CAP) { atomicAdd(&bar[XB_TMO], 1u); break; } }
    }
    nloc = mine > 0u ? mine : 1u; nx = cnt > 0u ? cnt : 1u;
}

__device__ __forceinline__ void xcd_barrier(const XcdBarrier& b, const int wave_) {
    asm volatile("s_waitcnt vmcnt(0)" ::: "memory");
    __syncthreads();
    int lane_; asm volatile("v_mbcnt_lo_u32_b32 %0, -1, 0\n\tv_mbcnt_hi_u32_b32 %0, -1, %0" : "=v"(lane_));
    if (wave_ == 0 && lane_ == 0) {
        unsigned* bar = b.bar;
        __builtin_amdgcn_s_waitcnt(0);
        unsigned nloc = b.st[0], nx = b.st[1];
        if (nloc == 0u) { xcd_barrier_complete(bar, b.x, nloc, nx); b.st[0] = nloc; b.st[1] = nx; }
        const unsigned old = xb_add(&bar[XB_XSUB(b.x)], 1u);
        const unsigned gen = old / nloc;
        if (old + 1u == (gen + 1u) * nloc) {
            __builtin_amdgcn_fence(__ATOMIC_RELEASE, "agent");
            asm volatile("s_waitcnt vmcnt(0)" ::: "memory");
            const unsigned og = xb_add(&bar[XB_TOP], 1u);
            const unsigned tg = og / nx;
            if (og + 1u == (tg + 1u) * nx) xb_add(&bar[XB_TOPGEN], 1u);
            else XB_SPIN(xb_ld(&bar[XB_TOPGEN]) == tg, bar);
            __builtin_amdgcn_fence(__ATOMIC_ACQUIRE, "agent");
            xb_add(&bar[XB_XGEN(b.x)], 1u);
            asm volatile("s_waitcnt vmcnt(0)" ::: "memory");
        } else {
            XB_SPIN(xb_ld(&bar[XB_XGEN(b.x)]) == gen, bar);
            __builtin_amdgcn_fence(__ATOMIC_ACQUIRE, "agent");
            asm volatile("s_waitcnt vmcnt(0)" ::: "memory");
        }
    }
    __syncthreads();
}
constexpr int NWAVES = 8;
constexpr int SEQ = 16384, DM = 4096, NH = 16, AW = 4096, PW = 8192, PGD = 2048;
constexpr float NORM_EPS = 1e-6f;
#ifndef MK_N_LAUNCHES
#define MK_N_LAUNCHES 1
#endif
constexpr int N_PHASES = 9;

constexpr size_t MiB = 1u << 20;
constexpr size_t WS_CTL = 0, CTL_ZERO_BYTES = 256 * 1024;
constexpr size_t WS_SS1 = 64 * 1024, WS_SS2 = 128 * 1024;
constexpr size_t WS_SS0 = 256 * 1024;
constexpr size_t WS_WO1 = 2 * MiB, WS_WG = 34 * MiB, WS_WO2 = 66 * MiB, WS_W2 = 130 * MiB;
constexpr size_t WS_Q = 258 * MiB, WS_K = 386 * MiB, WS_V = 514 * MiB, WS_Z = 642 * MiB, WS_O = 770 * MiB;
constexpr size_t WS_YF = 386 * MiB, WS_YL = 418 * MiB;
constexpr size_t WS_Z2 = 642 * MiB;
constexpr size_t WS_WINU = 898 * MiB;
constexpr size_t WS_END = 962 * MiB;
constexpr size_t OUT_W1 = 0, OUT_XB = 128 * MiB;
constexpr int CW_TMO = 0, CW_BAR = 4096, CW_PANEL = 8192;

constexpr int RING_BYTES = 131072;
constexpr int LDS_BYTES = 163840;
constexpr int MISC_OFF = LDS_BYTES - 256;
static_assert(dattn::LDS_END <= MISC_OFF && 8 * 64 * 65 * 4 <= MISC_OFF, "LDS map");

__device__ __forceinline__ float wave_sum(float v) {
#pragma unroll
    for (int o = 1; o < 64; o <<= 1) v += __shfl_xor(v, o);
    return v;
}
__device__ __forceinline__ void transpose_item(const float* W, int N, int nblk, bf16* WT, int ldt, const float* gain, LAS float* scr, int item, int lane) {
    const int kb = item / nblk, nb = item - kb * nblk, k0 = kb * 64, n0 = nb * 64;
    const int lr = lane >> 4, lc = (lane & 15) * 4;
    f32x4 ld[16];
#pragma unroll
    for (int i = 0; i < 16; ++i) ld[i] = *(const f32x4*)(W + (size_t)(k0 + 4 * i + lr) * N + n0 + lc);
#pragma unroll
    for (int i = 0; i < 16; ++i) { const int kk = 4 * i + lr; f32x4 v = ld[i];
        if (gain) { const float g = gain[k0 + kk]; v = v * g; }
        LAS float* s = scr + kk * 65 + lc; s[0] = v[0]; s[1] = v[1]; s[2] = v[2]; s[3] = v[3]; }
    LDS_WAIT(); asm volatile("" ::: "memory");
    const int c = lane & 7;
#pragma unroll 2
    for (int j = 0; j < 8; ++j) { const int n = (lane >> 3) + 8 * j; const LAS float* s = scr + (8 * c) * 65 + n;
        v4u o; o.x = pk2(s[0 * 65], s[1 * 65]); o.y = pk2(s[2 * 65], s[3 * 65]); o.z = pk2(s[4 * 65], s[5 * 65]); o.w = pk2(s[6 * 65], s[7 * 65]);
        *(v4u*)(WT + (size_t)(n0 + n) * ldt + k0 + 8 * c) = o; }
    LDS_WAIT(); asm volatile("" ::: "memory");
}

__device__ __forceinline__ void unpack8(const v4u q, float (&f)[8]) {
    f[0] = __uint_as_float(q.x << 16); f[1] = __uint_as_float(q.x & 0xffff0000u); f[2] = __uint_as_float(q.y << 16); f[3] = __uint_as_float(q.y & 0xffff0000u);
    f[4] = __uint_as_float(q.z << 16); f[5] = __uint_as_float(q.z & 0xffff0000u); f[6] = __uint_as_float(q.w << 16); f[7] = __uint_as_float(q.w & 0xffff0000u); }
struct Args { const float* in[12]; float* out; unsigned char* ws; int ph_lo, ph_hi; };

__global__ void __launch_bounds__(NWAVES * 64, 2) hybrid_fwd(Args args) {
    extern __shared__ __attribute__((aligned(16))) unsigned char lds_raw[];
    LAS unsigned char* lds = (LAS unsigned char*)lds_raw;
    volatile LAS unsigned* MISC = (volatile LAS unsigned*)(lds + MISC_OFF);
    const int tid0 = threadIdx.x, wave = __builtin_amdgcn_readfirstlane(tid0 >> 6);
    const int G = gridDim.x; const int bx = blockIdx.x; const int vcu = (G % 8 == 0) ? (bx % 8) * (G / 8) + bx / 8 : bx;
    unsigned char* ws = args.ws; unsigned char* outb = (unsigned char*)args.out;
    const float* x = args.in[0]; const float* norm_gains = args.in[1]; const float* final_gain = args.in[2]; const float* rel_bias = args.in[3];
    const float* attn_w_in = args.in[4]; const float* attn_lambda = args.in[5]; const float* attn_subln = args.in[6]; const float* attn_w_out = args.in[7];
    const float* pool_w_in = args.in[8]; const float* pool_w_group = args.in[9]; const float* pool_scale = args.in[10]; const float* pool_w_out = args.in[11];
    unsigned* ctl = (unsigned*)(ws + WS_CTL);
    float* ss0 = (float*)(ws + WS_SS0); float* ss1 = (float*)(ws + WS_SS1); float* ss2 = (float*)(ws + WS_SS2);
    bf16* W1t = (bf16*)(outb + OUT_W1); bf16* XB = (bf16*)(outb + OUT_XB);
    bf16* Wo1t = (bf16*)(ws + WS_WO1); bf16* Wgt = (bf16*)(ws + WS_WG); bf16* Wo2t = (bf16*)(ws + WS_WO2); bf16* W2t = (bf16*)(ws + WS_W2);
    bf16* Qp = (bf16*)(ws + WS_Q); bf16* Kp = (bf16*)(ws + WS_K); bf16* Vp = (bf16*)(ws + WS_V); bf16* Zp = (bf16*)(ws + WS_Z); bf16* Op = (bf16*)(ws + WS_O);
    bf16* WinU = (bf16*)(ws + WS_WINU);
    bf16* XB1 = Qp; bf16* Z2p = (bf16*)(ws + WS_Z2);
    float* xres = args.out;

    if (tid0 < 64) ((LAS unsigned*)(lds + MISC_OFF))[tid0] = 0u;
    __syncthreads();
    XcdBarrier bar; bar.bar = ctl + CW_BAR; bar.x = 0; bar.st = nullptr;
    if (MK_N_LAUNCHES == 1) bar = xcd_barrier_post(ctl + CW_BAR, MISC);
    const int lo = args.ph_lo, hi = args.ph_hi;
#define IN(k) (lo <= (k) && (k) < hi)
#define GRID_BAR(k) do { if (IN((k) + 1)) xcd_barrier(bar, wave); } while (0)

    if (IN(0)) {
        const int lane = dattn::fresh_lane();
        LAS float* scr = (LAS float*)lds + wave * (64 * 65);
        const int gw = vcu * NWAVES + wave, NGW = G * NWAVES;
        constexpr int I_W1 = (DM / 64) * (4 * AW / 64), I_WO1 = (AW / 64) * (DM / 64), I_W2Z = (DM / 64) * (PW / 64), I_WG = (PGD / 64) * (PGD / 64), I_WO2 = (PW / 64) * (DM / 64);
        constexpr int NITEMS = I_W1 + I_WO1 + I_W2Z + 4 * I_WG + I_WO2;
        for (int it = gw; it < NITEMS; it += NGW) {
            int r = it;
            if (r < I_W1) { transpose_item(attn_w_in, 4 * AW, 4 * AW / 64, W1t, DM, norm_gains, scr, r, lane); continue; } r -= I_W1;
            if (r < I_WO1) { transpose_item(attn_w_out, DM, DM / 64, Wo1t, AW, nullptr, scr, r, lane); continue; } r -= I_WO1;
            if (r < I_W2Z) { const int n0 = (r % (PW / 64)) * 64;
                transpose_item(pool_w_in + PW, 2 * PW, PW / 64, W2t + (size_t)((n0 >> 7) * 128 + 128) * DM, DM, norm_gains + DM, scr, r, lane); continue; } r -= I_W2Z;
            if (r < 4 * I_WG) { const int g = r / I_WG; transpose_item(pool_w_group + (size_t)g * PGD * PGD, PGD, PGD / 64, Wgt + (size_t)g * PGD * PGD, PGD, nullptr, scr, r - g * I_WG, lane); continue; } r -= 4 * I_WG;
            transpose_item(pool_w_out, DM, DM / 64, Wo2t, PW, nullptr, scr, r, lane);
        }
        {
            const int gt0 = gw * 64 + lane, NT0 = NGW * 64;
            for (int i0 = gt0; i0 < DM * (PW / 8); i0 += 4 * NT0) {
                f32x4 a[4], b4[4];
#pragma unroll
                for (int u = 0; u < 4; ++u) { const int i = i0 + u * NT0; if (i < DM * (PW / 8)) { const int k = i >> 10, c8 = (i & 1023) * 8;
                    a[u] = *(const f32x4*)(pool_w_in + (size_t)k * (2 * PW) + c8); b4[u] = *(const f32x4*)(pool_w_in + (size_t)k * (2 * PW) + c8 + 4); } }
#pragma unroll
                for (int u = 0; u < 4; ++u) { const int i = i0 + u * NT0; if (i < DM * (PW / 8)) { const int k = i >> 10, c8 = (i & 1023) * 8; const float gk = norm_gains[DM + k];
                    v4u o; o.x = pk2(a[u][0] * gk, a[u][1] * gk); o.y = pk2(a[u][2] * gk, a[u][3] * gk); o.z = pk2(b4[u][0] * gk, b4[u][1] * gk); o.w = pk2(b4[u][2] * gk, b4[u][3] * gk);
                    *(v4u*)(WinU + (size_t)k * PW + c8) = o; } } }
        }
        for (int m = gw; m < SEQ; m += NGW) {
            const f32x4* xr = (const f32x4*)(x + (size_t)m * DM) + lane; unsigned long long* o8 = (unsigned long long*)(XB + (size_t)m * DM) + lane; float s = 0.f;
            f32x4 xv[16];
#pragma unroll
            for (int j = 0; j < 16; ++j) xv[j] = xr[64 * j];
#pragma unroll
            for (int j = 0; j < 16; ++j) { const f32x4 v = xv[j]; s += (v[0] * v[0] + v[1] * v[1]) + (v[2] * v[2] + v[3] * v[3]);
                o8[64 * j] = (unsigned long long)pk2(v[0], v[1]) | ((unsigned long long)pk2(v[2], v[3]) << 32); }
            s = wave_sum(s); if (lane == 0) ss0[m] = s;
        }
        GRID_BAR(0);
    }
    if (IN(1)) {
        pg8::Gemm g{Wgt, WinU, PW, DM, PGD, PGD, PW, -1, 0, 3, PGD * 2}; pg8::StaticOrder S; S.init(PW, DM, G, bx);
        pg8::EpiPlain E{W2t, DM, 1};
        pg8::gemm_phase<pg8::EpiPlain, pg8::StaticOrder, true, true>(lds, g, S, E, wave);
    }
    if (IN(2)) {
        pg8::Gemm g{XB, W1t, SEQ, 4 * AW, DM, DM, DM, -1, 0, -1, 0}; pg8::StaticOrder S; S.init(SEQ, 4 * AW, G, bx);
        pg8::EpiNormSplit E{Qp, ss0, AW, (size_t)(WS_K - WS_Q) / 2, dattn::QSCALE, NORM_EPS, -1, 1.0f};
        pg8::gemm_phase<pg8::EpiNormSplit, pg8::StaticOrder, true, true>(lds, g, S, E, wave);
        GRID_BAR(2);
    }
    if (IN(3)) {
        const dattn::Tensors T{Qp, Kp, Vp, Zp, Op, rel_bias, attn_subln};
        dattn::attn_phase(lds, T, attn_lambda, vcu, G, wave);
        GRID_BAR(3);
    }
    if (IN(4)) {
        pg8::Gemm g{Op, Wo1t, SEQ, DM, AW, AW, AW, -1, 0, -1, 0};
        pg8::EpiResid<true, false, true> E{x, nullptr, nullptr, XB1, ss1, DM};
        { pg8::StaticOrder S; S.init(SEQ, DM, G, bx); pg8::gemm_phase<pg8::EpiResid<true, false, true>, pg8::StaticOrder, true, true>(lds, g, S, E, wave); }
        GRID_BAR(4);
    }
    bf16* MZp = (bf16*)(ws + WS_Z2); bf16* Yf = (bf16*)(ws + WS_YF); bf16* Yl = (bf16*)(ws + WS_YL);
    if (IN(5)) {
        pg8::Gemm g{XB1, W2t, SEQ, 2 * PW, DM, DM, DM, -1, 0, -1, 0}; pg8::StaticOrder S; S.init(SEQ, 2 * PW, G, bx);
        pg8::EpiPool E{MZp, Yf, Yl, ss1, pool_scale, lds + RING_BYTES, NORM_EPS};
        pg8::gemm_phase<pg8::EpiPool, pg8::StaticOrder, true, true>(lds, g, S, E, wave);
        GRID_BAR(5);
    }
    if (IN(6)) {
        const int gt = vcu * (NWAVES * 64) + wave * 64 + dattn::fresh_lane(), NT_ = G * NWAVES * 64;
        for (int task = gt; task < (SEQ / 256) * (PW / 8); task += NT_) {
            const int cc = task & 1023, pm = __builtin_amdgcn_readfirstlane(task >> 10), w = 2 << __builtin_amdgcn_readfirstlane(cc >> 8);
            const bf16* yp = Yl + ((size_t)(pm - 1) * 16) * PW + (size_t)cc * 8; const bf16* yc = Yf + ((size_t)pm * 16) * PW + (size_t)cc * 8; bf16* mz = MZp + ((size_t)pm * 256) * PW + (size_t)cc * 8;
            const f32x4 sc0 = *(const f32x4*)(pool_scale + cc * 8), sc1 = *(const f32x4*)(pool_scale + cc * 8 + 4);
            float scv[8], s[8];
#pragma unroll
            for (int e = 0; e < 8; ++e) { scv[e] = (e < 4 ? sc0[e] : sc1[e - 4]) * 0.6931471805599453f; s[e] = 0.f; }
            for (int r = 16 - w + 1; r < 16; ++r) if (pm > 0) { float f[8]; unpack8(*(const v4u*)(yp + (size_t)r * PW), f);
#pragma unroll
                for (int e = 0; e < 8; ++e) s[e] += f[e]; }
            for (int r = 0; r < 16; ++r) {
                float u[8], o_[8], z[8], a[8]; unpack8(*(const v4u*)(yc + (size_t)r * PW), u); unpack8(*(const v4u*)(mz + (size_t)r * PW), z);
#pragma unroll
                for (int e = 0; e < 8; ++e) { s[e] += u[e]; o_[e] = 0.f; }
                const int cnt = (pm == 0 && r + 1 < w) ? r + 1 : w; const float ic = 1.0f / (float)cnt;
#pragma unroll
                for (int e = 0; e < 8; ++e) a[e] = (s[e] * ic - u[e]) * scv[e] * (z[e] * __builtin_amdgcn_rcpf(1.0f + __builtin_amdgcn_exp2f(-z[e])));
                v4u o; o.x = pk2(a[0], a[1]); o.y = pk2(a[2], a[3]); o.z = pk2(a[4], a[5]); o.w = pk2(a[6], a[7]);
                *(v4u*)(mz + (size_t)r * PW) = o;
                const int ro = r + 1 - w;
                if (ro >= 0) unpack8(*(const v4u*)(yc + (size_t)ro * PW), o_); else if (pm > 0) unpack8(*(const v4u*)(yp + (size_t)(16 + ro) * PW), o_);
#pragma unroll
                for (int e = 0; e < 8; ++e) s[e] -= o_[e];
            }
        }
        GRID_BAR(6);
    }
    const bool fused_tail = (MK_N_LAUNCHES == 1) && (G % (DM / 256) == 0);
    if (IN(7)) {
        pg8::Gemm g{Z2p, Wo2t, SEQ, DM, PW, PW, PW, -1, 0, -1, 0};
        if (fused_tail) {
            pg8::PanelOrder S; S.init(SEQ, DM, G, vcu);
            pg8::EpiFinal E{XB1, xres, ss2, ctl + CW_PANEL, ctl + CW_BAR + XB_TMO, final_gain, DM, NORM_EPS, (unsigned)(DM / 256)};
            pg8::gemm_phase<pg8::EpiFinal, pg8::PanelOrder, true, true>(lds, g, S, E, wave);
        } else {
            pg8::StaticOrder S; S.init(SEQ, DM, G, bx);
            pg8::EpiResid<false, true, false> E{nullptr, XB1, xres, nullptr, ss2, DM};
            pg8::gemm_phase<pg8::EpiResid<false, true, false>, pg8::StaticOrder, true, true>(lds, g, S, E, wave);
            GRID_BAR(7);
        }
    }
    if (IN(8) && !fused_tail) {
        const int gt = vcu * (NWAVES * 64) + wave * 64 + dattn::fresh_lane(), NT_ = G * NWAVES * 64;
        const bool bad = (MK_N_LAUNCHES == 1) && (__hip_atomic_load(ctl + CW_BAR + XB_TMO, __ATOMIC_RELAXED, __HIP_MEMORY_SCOPE_AGENT) != 0u);
        const float qnan = __builtin_nanf("");
        for (int i0 = gt; i0 < SEQ * (DM / 4); i0 += 8 * NT_) {
            f32x4 v[8]; float sq[8];
#pragma unroll
            for (int u = 0; u < 8; ++u) { const int i = i0 + u * NT_; if (i < SEQ * (DM / 4)) { v[u] = ((const f32x4*)xres)[i]; sq[u] = ss2[i >> 10]; } }
#pragma unroll
            for (int u = 0; u < 8; ++u) { const int i = i0 + u * NT_; if (i < SEQ * (DM / 4)) { const float rs = 1.0f / sqrtf(sq[u] * (1.0f / 4096.0f) + NORM_EPS);
                const f32x4 gg = ((const f32x4*)final_gain)[i & 1023]; f32x4 r = v[u] * rs * gg; if (bad) r = (f32x4){qnan, qnan, qnan, qnan};
                ((f32x4*)xres)[i] = r; } } }
    }
#undef IN
#undef GRID_BAR
}

extern "C" void kernel_launch(void* const* d_in, const int* in_sizes, int n_in, void* d_out, int out_size, void* d_ws, size_t ws_size, hipStream_t stream) {
    static int grid = 0;
    if (grid == 0) {
        if (n_in != 12 || in_sizes[0] != SEQ * DM || out_size != SEQ * DM || ws_size < WS_END) {
            fprintf(stderr, "kernel_launch: built for 12 inputs, x/out of %d floats, >= %zu bytes of workspace; got n_in %d, in0 %d, out %d, ws %zu; nothing launched\n", SEQ * DM, (size_t)WS_END, n_in, n_in > 0 ? in_sizes[0] : -1, out_size, ws_size); grid = -1; return; }
        int dev = 0, cus = 0, per_cu = 0;
        if (hipGetDevice(&dev) != hipSuccess || hipDeviceGetAttribute(&cus, hipDeviceAttributeMultiprocessorCount, dev) != hipSuccess) { fprintf(stderr, "kernel_launch: device query failed\n"); grid = -1; return; }
        if (hipFuncSetAttribute((const void*)hybrid_fwd, hipFuncAttributeMaxDynamicSharedMemorySize, LDS_BYTES) != hipSuccess) { fprintf(stderr, "kernel_launch: hipFuncSetAttribute failed\n"); grid = -1; return; }
        if (hipOccupancyMaxActiveBlocksPerMultiprocessor(&per_cu, (const void*)hybrid_fwd, NWAVES * 64, LDS_BYTES) != hipSuccess || per_cu < 1)
            fprintf(stderr, "kernel_launch: note: occupancy query reports %d workgroups per CU\n", per_cu);
        (void)hipGetLastError();
        grid = cus;
    }
    if (grid < 0) return;
    if (hipMemsetAsync((char*)d_ws + WS_CTL, 0, CTL_ZERO_BYTES, stream) != hipSuccess) { fprintf(stderr, "kernel_launch: hipMemsetAsync failed\n"); return; }
    Args a{};
    for (int i = 0; i < 12; ++i) a.in[i] = (const float*)d_in[i];
    a.out = (float*)d_out; a.ws = (unsigned char*)d_ws;
    for (int li = 0; li < MK_N_LAUNCHES; ++li) {
        a.ph_lo = (MK_N_LAUNCHES == 1) ? 0 : li; a.ph_hi = (MK_N_LAUNCHES == 1) ? N_PHASES : li + 1;
        hipLaunchKernelGGL(hybrid_fwd, dim3(grid), dim3(NWAVES * 64), LDS_BYTES, stream, a);
        const hipError_t le = hipPeekAtLastError();
        if (le != hipSuccess) { fprintf(stderr, "kernel_launch: launch %d failed: %s\n", li, hipGetErrorName(le)); break; }
    }
}
```

```cpp
#include <hip/hip_runtime.h>
#include <cstdio>
#include <cstdint>
#include <cmath>
namespace pg8 {
#define PG8_LAS __attribute__((address_space(3)))
typedef unsigned short bf16_t;
typedef short bf16x8 __attribute__((ext_vector_type(8)));
typedef float f32x4 __attribute__((ext_vector_type(4)));
typedef unsigned u32x4 __attribute__((ext_vector_type(4)));
typedef unsigned u32x2 __attribute__((ext_vector_type(2)));
constexpr int BM = 256, BK = 64, HALF = 128, HTB = HALF * BK * 2  , STAGE_BYTES = 8 * HTB, NXCD = 8, WGM = 4;

__host__ __device__ __forceinline__ int lds_byte(int r, int c) { const int st = (r >> 4) * 2 + (c >> 5), rr = r & 15, cc = c & 31, ob = rr * 64 + cc * 2; return st * 1024 + (ob ^ (((ob >> 9) & 1) << 5)); }
__host__ __device__ __forceinline__ void stage_rc(int b, int& R, int& C) { const int st = b / 1024, sb = b % 1024, swz = sb ^ (((sb >> 9) & 1) << 5); R = (st >> 1) * 16 + swz / 64; C = (st & 1) * 32 + (swz % 64) / 2; }
__host__ __device__ __forceinline__ int perm32(int rho) { const int n = rho >> 4, i = rho & 15; return 8 * (i >> 2) + 4 * n + (i & 3); }

struct Unit { int pm, pn; };
struct Gemm { const bf16_t* A; const bf16_t* Bt; int M, N, K, lda, ldb, gshift, gstride, bshift, bstride;
    __device__ __forceinline__ size_t aoff(int pn) const { return gshift >= 0 ? (size_t)(pn >> gshift) * (size_t)gstride : (size_t)0; }
    __device__ __forceinline__ size_t boff(int pm) const { return bshift >= 0 ? (size_t)(pm >> bshift) * (size_t)bstride : (size_t)0; } };

struct StaticOrder {
    int nM, nN, nwg, G, c;
    __host__ __device__ void init(int M, int N, int G_, int c_) { nM = M / BM; nN = N / BM; nwg = nM * nN; G = G_; c = c_; }
    __host__ __device__ bool next(int i, Unit& u) const {
        const long L = (long)i * G + c; if (L >= nwg) return false;
        int wgid = (int)L; { const int q = nwg / NXCD, r = nwg % NXCD, xcd = wgid % NXCD, off = wgid / NXCD; wgid = (xcd < r ? xcd * (q + 1) : r * (q + 1) + (xcd - r) * q) + off; }
        const int nig = WGM * nN, gid = wgid / nig, fm = gid * WGM, gsz = (nM - fm) < WGM ? (nM - fm) : WGM;
        u.pm = fm + ((wgid % nig) % gsz); u.pn = (wgid % nig) / gsz; return true;
    }
    __device__ __forceinline__ void a_ready(const Unit&) const {}
    __device__ __forceinline__ void done(const Unit&) const {}
};

struct PanelOrder {
    int nN, nwg, G, c;
    __host__ __device__ void init(int M, int N, int G_, int c_) { nN = N / BM; nwg = (M / BM) * nN; G = G_; c = c_; }
    __host__ __device__ bool next(int i, Unit& u) const {
        const long L0 = (long)i * G; if (L0 + c >= nwg) return false;
        if (nN % 16 == 0 && G % 64 == 0 && nwg % G == 0 && ((nwg / nN) % (G / 16)) == 0) {
            const int ncs = nN / 16, rg = i / ncs, sc = i - rg * ncs;
            const int q = c >> 6, h = (c >> 5) & 1, j = c & 31;
            u.pm = rg * (G / 16) + q * 4 + (j & 3); u.pn = sc * 16 + h * 8 + (j >> 2); return true; }
        const long L = L0 + c; u.pm = (int)(L / nN); u.pn = (int)(L % nN); return true;
    }
    __device__ __forceinline__ void a_ready(const Unit&) const {}
    __device__ __forceinline__ void done(const Unit&) const {}
};

__device__ __forceinline__ unsigned cvt_pk_bf16(float lo, float hi) { unsigned r; asm volatile("v_cvt_pk_bf16_f32 %0, %1, %2" : "=v"(r) : "v"(lo), "v"(hi)); return r; }
typedef float f32x2 __attribute__((ext_vector_type(2)));
template <class Epi, class Sched, bool ALIGN_EPI = false, bool SP2 = false>
__device__ __forceinline__ void gemm_phase(PG8_LAS unsigned char* lds, const Gemm g, const Sched& S, const Epi& E, const int wid) {
    int lane; asm volatile("v_mbcnt_lo_u32_b32 %0, -1, 0\n\tv_mbcnt_hi_u32_b32 %0, -1, %0" : "=v"(lane));
    const int tid = wid * 64 + lane, wr = wid >> 2, wc = wid & 3, fr = lane & 15, fq = lane >> 4;
    const int K = g.K, nt = K / BK;
    unsigned voffA[2], voffB[2];
#pragma unroll
    for (int i = 0; i < 2; ++i) { int R, C; stage_rc(tid * 16 + i * 8192, R, C); const int Rb = Epi::PERM ? ((R & ~31) + perm32(R & 31)) : R;
        voffA[i] = (unsigned)(R * g.lda + C) * 2u; voffB[i] = (unsigned)(Rb * g.ldb + C) * 2u; }
    const size_t kstep = (size_t)(BK * 2);
    const size_t hstepA = (size_t)HALF * g.lda * 2, hstepB = (size_t)HALF * g.ldb * 2;
    const size_t tstepA = 2 * hstepA, tstepB = 2 * hstepB;
    const unsigned ldsw = (unsigned)wid * 1024u;
    const int aoff = lds_byte(wr * 64 + fr, fq * 8), boff = lds_byte(wc * 32 + fr, fq * 8);
#define PG8_SA(b, h) (((b) * 2 + (h)) * HTB)
#define PG8_SB(b, h) ((4 + (b) * 2 + (h)) * HTB)
#define PG8_STAGE(bufoff, gbase, voff) do { _Pragma("unroll") for (int _i = 0; _i < 2; ++_i) \
        __builtin_amdgcn_global_load_lds((const unsigned*)((const char*)(gbase) + (voff)[_i]), (PG8_LAS unsigned*)(lds + (bufoff) + ldsw + _i * 8192), 16, 0, 0); } while (0)
#define PG8_LDA(dst, b, h) do { _Pragma("unroll") for (int m = 0; m < 4; ++m) _Pragma("unroll") for (int k = 0; k < 2; ++k) dst[m][k] = *(const PG8_LAS bf16x8*)(lds + PG8_SA(b, h) + aoff + m * 2048 + k * 1024); } while (0)
#define PG8_LDB(dst, b, h) do { _Pragma("unroll") for (int n = 0; n < 2; ++n) _Pragma("unroll") for (int k = 0; k < 2; ++k) dst[n][k] = *(const PG8_LAS bf16x8*)(lds + PG8_SB(b, h) + boff + n * 2048 + k * 1024); } while (0)
#define PG8_MMA(ai, bj, At, Bt) do { __builtin_amdgcn_s_setprio(1); _Pragma("unroll") for (int m = 0; m < 4; ++m) _Pragma("unroll") for (int n = 0; n < 2; ++n) _Pragma("unroll") for (int k = 0; k < 2; ++k) \
        acc[ai][bj][m][n] = (Epi::YNT && (bj) == 0) ? __builtin_amdgcn_mfma_f32_16x16x32_bf16(At[m][k], Bt[n][k], acc[ai][bj][m][n], 0, 0, 0) : __builtin_amdgcn_mfma_f32_16x16x32_bf16(Bt[n][k], At[m][k], acc[ai][bj][m][n], 0, 0, 0); __builtin_amdgcn_s_setprio(0); } while (0)
#define PG8_WAIT_V(n) asm volatile("s_waitcnt vmcnt(" #n ")" ::: "memory")
#define PG8_WAIT_L(n) asm volatile("s_waitcnt lgkmcnt(" #n ")" ::: "memory")
#define PG8_BAR __builtin_amdgcn_s_barrier()
#define PG8_SCHED __builtin_amdgcn_sched_barrier(0)
    Unit cur, nxt; int ui = 0;
    if (!S.next(0, cur)) return;
    f32x4 acc[2][2][4][2];
#pragma unroll
    for (int a = 0; a < 2; ++a)
#pragma unroll
        for (int b = 0; b < 2; ++b)
#pragma unroll
            for (int m = 0; m < 4; ++m)
#pragma unroll
                for (int n = 0; n < 2; ++n) acc[a][b][m][n] = (f32x4){0.f, 0.f, 0.f, 0.f};
    bf16x8 At[4][2], B0[2][2], B1[2][2];
    const char* cA = (const char*)g.A + (size_t)cur.pm * tstepA + g.aoff(cur.pn); const char* cB = (const char*)g.Bt + (size_t)cur.pn * tstepB + g.boff(cur.pm);
    S.a_ready(cur);
    if constexpr (SP2) {
        PG8_STAGE(PG8_SB(0, 0), cB, voffB); PG8_STAGE(PG8_SB(0, 1), cB + hstepB, voffB); PG8_STAGE(PG8_SA(0, 0), cA, voffA); PG8_STAGE(PG8_SA(0, 1), cA + hstepA, voffA);
        if (wr == 1) PG8_BAR;
        PG8_WAIT_V(2); PG8_BAR;
        PG8_STAGE(PG8_SB(1, 0), cB + kstep, voffB); PG8_STAGE(PG8_SA(1, 0), cA + kstep, voffA); PG8_STAGE(PG8_SB(1, 1), cB + hstepB + kstep, voffB);
        PG8_WAIT_V(6); PG8_BAR;
    } else {
        PG8_STAGE(PG8_SB(0, 0), cB, voffB); PG8_STAGE(PG8_SA(0, 0), cA, voffA); PG8_STAGE(PG8_SB(0, 1), cB + hstepB, voffB); PG8_STAGE(PG8_SA(0, 1), cA + hstepA, voffA);
        if (wr == 1) PG8_BAR;
        PG8_WAIT_V(4); PG8_BAR;
        PG8_STAGE(PG8_SB(1, 0), cB + kstep, voffB); PG8_STAGE(PG8_SA(1, 0), cA + kstep, voffA); PG8_STAGE(PG8_SB(1, 1), cB + hstepB + kstep, voffB);
        PG8_WAIT_V(6); PG8_BAR;
    }
    for (;;) {
        const bool has_next = S.next(ui + 1, nxt);
        const char* nA = has_next ? (const char*)g.A + (size_t)nxt.pm * tstepA + g.aoff(nxt.pn) : cA; const char* nB = has_next ? (const char*)g.Bt + (size_t)nxt.pn * tstepB + g.boff(nxt.pm) : cB;
        for (int t = 0; t < nt; t += 2) {
            const bool last = (t == nt - 2);
            const char* a1 = cA + (size_t)(t + 1) * kstep;
            const char* a2 = last ? nA : cA + (size_t)(t + 2) * kstep; const char* b2 = last ? nB : cB + (size_t)(t + 2) * kstep;
            const char* a3 = a2 + kstep; const char* b3 = b2 + kstep;
            if (last && has_next) S.a_ready(nxt);
            if constexpr (SP2) {
            PG8_LDB(B0, 0, 0); PG8_LDB(B1, 0, 1); PG8_SCHED; PG8_LDA(At, 0, 0); PG8_STAGE(PG8_SA(1, 1), a1 + hstepA, voffA);
            PG8_WAIT_V(8); PG8_WAIT_L(0); PG8_BAR; PG8_MMA(0, 0, At, B0); PG8_MMA(0, 1, At, B1); PG8_BAR; PG8_SCHED;
            PG8_LDA(At, 0, 1); PG8_STAGE(PG8_SB(0, 0), b2, voffB); PG8_STAGE(PG8_SB(0, 1), b2 + hstepB, voffB); PG8_STAGE(PG8_SA(0, 0), a2, voffA);
            PG8_WAIT_V(8); PG8_WAIT_L(0); PG8_BAR; PG8_MMA(1, 0, At, B0); PG8_MMA(1, 1, At, B1); PG8_BAR; PG8_SCHED;
            PG8_LDB(B0, 1, 0); PG8_LDB(B1, 1, 1); PG8_SCHED; PG8_LDA(At, 1, 0); PG8_STAGE(PG8_SA(0, 1), a2 + hstepA, voffA);
            PG8_WAIT_V(8); PG8_WAIT_L(0); PG8_BAR; PG8_MMA(0, 0, At, B0); PG8_MMA(0, 1, At, B1); PG8_BAR; PG8_SCHED;
            PG8_LDA(At, 1, 1); PG8_STAGE(PG8_SB(1, 0), b3, voffB); PG8_STAGE(PG8_SB(1, 1), b3 + hstepB, voffB); PG8_STAGE(PG8_SA(1, 0), a3, voffA);
            PG8_WAIT_V(8); PG8_WAIT_L(0); PG8_BAR; PG8_MMA(1, 0, At, B0); PG8_MMA(1, 1, At, B1); PG8_BAR; PG8_SCHED;
            } else {
            PG8_LDB(B0, 0, 0); PG8_SCHED; PG8_LDA(At, 0, 0); PG8_STAGE(PG8_SA(1, 1), a1 + hstepA, voffA);
            PG8_WAIT_L(8); PG8_BAR; PG8_WAIT_L(0); PG8_MMA(0, 0, At, B0); PG8_BAR; PG8_SCHED;
            PG8_LDB(B1, 0, 1); PG8_STAGE(PG8_SB(0, 0), b2, voffB);
            PG8_BAR; PG8_WAIT_L(0); PG8_MMA(0, 1, At, B1); PG8_BAR;
            PG8_LDA(At, 0, 1); PG8_STAGE(PG8_SA(0, 0), a2, voffA);
            PG8_BAR; PG8_WAIT_L(0); PG8_MMA(1, 0, At, B0); PG8_BAR; PG8_SCHED;
            PG8_STAGE(PG8_SB(0, 1), b2 + hstepB, voffB);
            PG8_WAIT_V(6); PG8_BAR; PG8_MMA(1, 1, At, B1); PG8_BAR;
            PG8_LDB(B0, 1, 0); PG8_SCHED; PG8_LDA(At, 1, 0); PG8_STAGE(PG8_SA(0, 1), a2 + hstepA, voffA);
            PG8_WAIT_L(8); PG8_BAR; PG8_WAIT_L(0); PG8_MMA(0, 0, At, B0); PG8_BAR; PG8_SCHED;
            PG8_LDB(B1, 1, 1); PG8_STAGE(PG8_SB(1, 0), b3, voffB);
            PG8_BAR; PG8_WAIT_L(0); PG8_MMA(0, 1, At, B1); PG8_BAR;
            PG8_LDA(At, 1, 1); PG8_STAGE(PG8_SA(1, 0), a3, voffA);
            PG8_BAR; PG8_WAIT_L(0); PG8_MMA(1, 0, At, B0); PG8_BAR; PG8_SCHED;
            PG8_STAGE(PG8_SB(1, 1), b3 + hstepB, voffB);
            PG8_WAIT_V(6); PG8_BAR; PG8_MMA(1, 1, At, B1); PG8_BAR;
            }
        }
        if constexpr (ALIGN_EPI) { if (wr == 0) PG8_BAR; }
        if constexpr (!Epi::AFTER_DRAIN) { E(acc, cur, wr, wc, fr, fq); S.done(cur); }
        if (!has_next) break;
#pragma unroll
        for (int a = 0; a < 2; ++a)
#pragma unroll
            for (int b = 0; b < 2; ++b)
#pragma unroll
                for (int m = 0; m < 4; ++m)
#pragma unroll
                    for (int n = 0; n < 2; ++n) acc[a][b][m][n] = (f32x4){0.f, 0.f, 0.f, 0.f};
        cur = nxt; cA = nA; cB = nB; ++ui;
        if constexpr (ALIGN_EPI) { if (wr == 1) PG8_BAR; }
    }
    PG8_WAIT_V(0);
    if constexpr (!ALIGN_EPI) { if (wr == 0) PG8_BAR; }
    PG8_BAR;
    if constexpr (Epi::AFTER_DRAIN) { E.fused(acc, cur, wr, wc, fr, fq, lds, wid, lane); S.done(cur); }
#undef PG8_SA
#undef PG8_SB
#undef PG8_STAGE
#undef PG8_LDA
#undef PG8_LDB
#undef PG8_MMA
#undef PG8_WAIT_V
#undef PG8_WAIT_L
#undef PG8_BAR
#undef PG8_SCHED
}
}
namespace pg8 {
__device__ __forceinline__ u32x4 pack8_bf16(const f32x4 v0, const f32x4 v1) { u32x4 w; w.x = cvt_pk_bf16(v0[0], v0[1]); w.y = cvt_pk_bf16(v0[2], v0[3]); w.z = cvt_pk_bf16(v1[0], v1[1]); w.w = cvt_pk_bf16(v1[2], v1[3]); return w; }

struct EpiNormSplit {
    static constexpr bool PERM = true, AFTER_DRAIN = false, YNT = false;
    bf16_t* O; const float* ss; int split_cols; size_t split_stride; float scale0; float eps; int zplane; float scalez;
    __device__ __forceinline__ void operator()(const f32x4 (&acc)[2][2][4][2], const Unit& u, int wr, int wc, int fr, int fq) const {
        const int row0 = u.pm * BM + wr * 64 + fr; int colt = u.pn * BM; bf16_t* base = O;
        const int t = colt / split_cols; base += (size_t)t * split_stride; colt -= t * split_cols;
        const float sc = (t == 0) ? scale0 : ((t == zplane) ? scalez : 1.f);
        const int col0 = colt + wc * 32 + 8 * fq;
        float ssv[2][4];
#pragma unroll
        for (int ai = 0; ai < 2; ++ai)
#pragma unroll
            for (int m = 0; m < 4; ++m) ssv[ai][m] = ss[row0 + ai * HALF + m * 16];
#pragma unroll
        for (int ai = 0; ai < 2; ++ai)
#pragma unroll
            for (int m = 0; m < 4; ++m) { const int row = row0 + ai * HALF + m * 16;
                const float rs = sc * __builtin_amdgcn_rsqf(ssv[ai][m] * (1.0f / 4096.0f) + eps);
                bf16_t* rowp = base + (size_t)row * split_cols + col0;
#pragma unroll
                for (int bj = 0; bj < 2; ++bj) { const f32x4 v0 = acc[ai][bj][m][0] * rs, v1 = acc[ai][bj][m][1] * rs; *(u32x4*)(rowp + bj * HALF) = pack8_bf16(v0, v1); } }
    }
};

struct EpiPlain {
    static constexpr bool PERM = true, AFTER_DRAIN = false, YNT = false;
    bf16_t* O; int ldc; int ymap;
    __device__ __forceinline__ void operator()(const f32x4 (&acc)[2][2][4][2], const Unit& u, int wr, int wc, int fr, int fq) const {
        const int row0 = u.pm * BM + wr * 64 + fr, col0 = u.pn * BM + wc * 32 + 8 * fq;
#pragma unroll
        for (int ai = 0; ai < 2; ++ai)
#pragma unroll
            for (int m = 0; m < 4; ++m) { int row = row0 + ai * HALF + m * 16; if (ymap) row = ((row >> 7) << 8) + (row & 127);
                bf16_t* rowp = O + (size_t)row * ldc + col0;
#pragma unroll
                for (int bj = 0; bj < 2; ++bj) *(u32x4*)(rowp + bj * HALF) = pack8_bf16(acc[ai][bj][m][0], acc[ai][bj][m][1]); }
    }
};

template <bool F32BASE, bool WOUT, bool WXB>
struct EpiResid {
    static constexpr bool PERM = true, AFTER_DRAIN = false, YNT = false;
    const float* base; const bf16_t* baseh; float* out; bf16_t* xb; float* ss; int ldc;
    __device__ __forceinline__ void operator()(const f32x4 (&acc)[2][2][4][2], const Unit& u, int wr, int wc, int fr, int fq) const {
        const int row0 = u.pm * BM + wr * 64 + fr, col0 = u.pn * BM + wc * 32 + 8 * fq;
#pragma unroll
        for (int ai = 0; ai < 2; ++ai) {
            f32x4 bf[F32BASE ? 4 : 1][2][2]; u32x4 bh[F32BASE ? 1 : 4][2];
#pragma unroll
            for (int m = 0; m < 4; ++m)
#pragma unroll
                for (int bj = 0; bj < 2; ++bj) { const size_t off = (size_t)(row0 + ai * HALF + m * 16) * ldc + col0 + bj * HALF;
                    if constexpr (F32BASE) { bf[m][bj][0] = *(const f32x4*)(base + off); bf[m][bj][1] = *(const f32x4*)(base + off + 4); }
                    else bh[m][bj] = *(const u32x4*)(baseh + off); }
#pragma unroll
            for (int m = 0; m < 4; ++m) { const int row = row0 + ai * HALF + m * 16; const size_t off = (size_t)row * ldc + col0; float sq = 0.f;
#pragma unroll
                for (int bj = 0; bj < 2; ++bj) { f32x4 b0, b1;
                    if constexpr (F32BASE) { b0 = bf[m][bj][0]; b1 = bf[m][bj][1]; }
                    else { const u32x4 hq = bh[m][bj];
                        b0[0] = __uint_as_float(hq.x << 16); b0[1] = __uint_as_float(hq.x & 0xffff0000u); b0[2] = __uint_as_float(hq.y << 16); b0[3] = __uint_as_float(hq.y & 0xffff0000u);
                        b1[0] = __uint_as_float(hq.z << 16); b1[1] = __uint_as_float(hq.z & 0xffff0000u); b1[2] = __uint_as_float(hq.w << 16); b1[3] = __uint_as_float(hq.w & 0xffff0000u); }
                    const f32x4 v0 = acc[ai][bj][m][0] + b0, v1 = acc[ai][bj][m][1] + b1;
                    if constexpr (WOUT) { *(f32x4*)(out + off + bj * HALF) = v0; *(f32x4*)(out + off + bj * HALF + 4) = v1; }
                    sq += (v0[0] * v0[0] + v0[1] * v0[1]) + (v0[2] * v0[2] + v0[3] * v0[3]) + (v1[0] * v1[0] + v1[1] * v1[1]) + (v1[2] * v1[2] + v1[3] * v1[3]);
                    if constexpr (WXB) *(u32x4*)(xb + off + bj * HALF) = pack8_bf16(v0, v1); }
                sq += __shfl_xor(sq, 16); sq += __shfl_xor(sq, 32);
                if (fq == 0) unsafeAtomicAdd(ss + row, sq); }
        }
    }
};

struct EpiPool {
    static constexpr bool PERM = true, AFTER_DRAIN = false, YNT = true;
    bf16_t* MZ; bf16_t* Yf; bf16_t* Yl; const float* ss; const float* pscale; PG8_LAS unsigned char* xl; float eps;
    __device__ __forceinline__ void operator()(const f32x4 (&acc)[2][2][4][2], const Unit& u, int wr, int wc, int fr, int fq) const {
        constexpr int LDC = 8192;
        const int wid = wr * 4 + wc, lane = fq * 16 + fr;
        const int w = 2 << (u.pn >> 4);
        const int rowb = u.pm * BM + wr * 64, colb = u.pn * HALF + wc * 32 + 8 * fq;
        PG8_LAS float* RS = (PG8_LAS float*)xl + wid * 128;
        PG8_LAS u32x2* HALO = (PG8_LAS u32x2*)(xl + 4096);
        float rst[2][4];
#pragma unroll
        for (int ai = 0; ai < 2; ++ai)
#pragma unroll
            for (int m = 0; m < 4; ++m) rst[ai][m] = ss[rowb + ai * HALF + m * 16 + fr];
        const f32x4 ps0 = *(const f32x4*)(pscale + colb) * 0.6931471805599453f, ps1 = *(const f32x4*)(pscale + colb + 4) * 0.6931471805599453f;
#pragma unroll
        for (int ai = 0; ai < 2; ++ai)
#pragma unroll
            for (int m = 0; m < 4; ++m) { rst[ai][m] = __builtin_amdgcn_rsqf(rst[ai][m] * (1.0f / 4096.0f) + eps); if (fq == 0) RS[(ai * 4 + m) * 16 + fr] = rst[ai][m]; }
        asm volatile("s_waitcnt lgkmcnt(0)" ::: "memory");
        u32x2 ypk[2][4][2];
#pragma unroll
        for (int ai = 0; ai < 2; ++ai)
#pragma unroll
            for (int m = 0; m < 4; ++m) { const f32x4 rn = *(const PG8_LAS f32x4*)(RS + (ai * 4 + m) * 16 + 4 * fq);
#pragma unroll
                for (int n = 0; n < 2; ++n) { const f32x4 v = acc[ai][0][m][n] * rn; ypk[ai][m][n].x = cvt_pk_bf16(v[0], v[1]); ypk[ai][m][n].y = cvt_pk_bf16(v[2], v[3]); } }
#pragma unroll
        for (int n = 0; n < 2; ++n) {
            if (wr == 0) { HALO[((0 * 4 + wc) * 2 + n) * 64 + lane] = ypk[0][3][n]; HALO[((2 * 4 + wc) * 2 + n) * 64 + lane] = ypk[1][3][n]; }
            else HALO[((1 * 4 + wc) * 2 + n) * 64 + lane] = ypk[0][3][n]; }
        asm volatile("s_waitcnt lgkmcnt(0)" ::: "memory");
        __syncthreads();
        u32x2 hal[2][2];
#pragma unroll
        for (int n = 0; n < 2; ++n) {
            hal[0][n] = (u32x2){0u, 0u}; if (wr == 1) hal[0][n] = HALO[((0 * 4 + wc) * 2 + n) * 64 + lane];
            hal[1][n] = HALO[(((wr == 0 ? 1 : 2) * 4 + wc) * 2 + n) * 64 + lane]; }
        const float invw = 1.0f / (float)w;
        float cp[4], cc[4], ci[4];
#pragma unroll
        for (int e = 0; e < 4; ++e) { const int p = 4 * fq + e, dp = fr + 16 - p, dc = fr - p;
            cp[e] = (dp < w) ? invw : 0.f; cc[e] = (dc == 0) ? invw - 1.0f : ((dc > 0 && dc < w) ? invw : 0.f); ci[e] = (dc == 0) ? 1.0f : 0.f; }
        u32x4 bpw, biw; bpw.x = cvt_pk_bf16(cp[0], cp[1]); bpw.y = cvt_pk_bf16(cp[2], cp[3]); bpw.z = cvt_pk_bf16(cc[0], cc[1]); bpw.w = cvt_pk_bf16(cc[2], cc[3]);
        biw.x = 0u; biw.y = 0u; biw.z = cvt_pk_bf16(ci[0], ci[1]); biw.w = cvt_pk_bf16(ci[2], ci[3]);
        const bf16x8 bp = __builtin_bit_cast(bf16x8, bpw), bi = __builtin_bit_cast(bf16x8, biw);
        const f32x4 zero4 = (f32x4){0.f, 0.f, 0.f, 0.f};
        float zf; asm volatile("v_mov_b32 %0, 0" : "=v"(zf));
#pragma unroll
        for (int ai = 0; ai < 2; ++ai)
#pragma unroll
            for (int m = 0; m < 4; ++m) {
                const int row = rowb + ai * HALF + m * 16 + fr; bf16_t* dst = MZ + (size_t)row * LDC + colb;
                const float zs = rst[ai][m] * 1.4426950408889634f;
                f32x4 z0 = acc[ai][1][m][0] * zs, z1 = acc[ai][1][m][1] * zs;
                const bool first = (ai == 0 && m == 0) && (wr == 0), lastb = (ai == 1 && m == 3) && (wr == 1);
                if (first || lastb) {
                    u32x4 a0, a1; a0.x = 0u; a0.y = 0u; a0.z = ypk[ai][m][0].x; a0.w = ypk[ai][m][0].y; a1.x = 0u; a1.y = 0u; a1.z = ypk[ai][m][1].x; a1.w = ypk[ai][m][1].y;
                    const f32x4 y0 = __builtin_amdgcn_mfma_f32_16x16x32_bf16(__builtin_bit_cast(bf16x8, a0), bi, zero4, 0, 0, 0), y1 = __builtin_amdgcn_mfma_f32_16x16x32_bf16(__builtin_bit_cast(bf16x8, a1), bi, zero4, 0, 0, 0);
                    bf16_t* yd = (first ? Yf : Yl) + ((size_t)u.pm * 16 + fr) * LDC + colb;
                    *(u32x4*)yd = pack8_bf16(y0 + zf, y1 + zf); }
                if (first) { *(u32x4*)dst = pack8_bf16(z0, z1); }
                else {
                    const u32x2 pv0 = (m > 0) ? ypk[ai][m > 0 ? m - 1 : 0][0] : hal[ai][0], pv1 = (m > 0) ? ypk[ai][m > 0 ? m - 1 : 0][1] : hal[ai][1];
                    u32x4 a0, a1; a0.x = pv0.x; a0.y = pv0.y; a0.z = ypk[ai][m][0].x; a0.w = ypk[ai][m][0].y; a1.x = pv1.x; a1.y = pv1.y; a1.z = ypk[ai][m][1].x; a1.w = ypk[ai][m][1].y;
                    f32x4 d0 = __builtin_amdgcn_mfma_f32_16x16x32_bf16(__builtin_bit_cast(bf16x8, a0), bp, zero4, 0, 0, 0), d1 = __builtin_amdgcn_mfma_f32_16x16x32_bf16(__builtin_bit_cast(bf16x8, a1), bp, zero4, 0, 0, 0);
#pragma unroll
                    for (int e = 0; e < 4; ++e) { d0[e] *= ps0[e] * (z0[e] * __builtin_amdgcn_rcpf(1.0f + __builtin_amdgcn_exp2f(-z0[e]))); d1[e] *= ps1[e] * (z1[e] * __builtin_amdgcn_rcpf(1.0f + __builtin_amdgcn_exp2f(-z1[e]))); }
                    *(u32x4*)dst = pack8_bf16(d0, d1); }
            }
    }
};

struct EpiFinal {
    static constexpr bool PERM = true, AFTER_DRAIN = false, YNT = false;
    const bf16_t* baseh; float* out; float* ss; unsigned* cnt; unsigned* tmo; const float* gain; int ldc; float eps; unsigned nown;
    __device__ __forceinline__ void unpk(const u32x4 hq, f32x4& b0, f32x4& b1) const {
        b0[0] = __uint_as_float(hq.x << 16); b0[1] = __uint_as_float(hq.x & 0xffff0000u); b0[2] = __uint_as_float(hq.y << 16); b0[3] = __uint_as_float(hq.y & 0xffff0000u);
        b1[0] = __uint_as_float(hq.z << 16); b1[1] = __uint_as_float(hq.z & 0xffff0000u); b1[2] = __uint_as_float(hq.w << 16); b1[3] = __uint_as_float(hq.w & 0xffff0000u); }
    __device__ __forceinline__ void operator()(const f32x4 (&acc)[2][2][4][2], const Unit& u, int wr, int wc, int fr, int fq) const {
        const int row0 = u.pm * BM + wr * 64 + fr, col0 = u.pn * BM + wc * 32 + 8 * fq;
        u32x4 bh[2][4][2];
#pragma unroll
        for (int ai = 0; ai < 2; ++ai)
#pragma unroll
            for (int m = 0; m < 4; ++m)
#pragma unroll
                for (int bj = 0; bj < 2; ++bj) bh[ai][m][bj] = *(const u32x4*)(baseh + (size_t)(row0 + ai * HALF + m * 16) * ldc + col0 + bj * HALF);
        f32x4 gg[2][2];
#pragma unroll
        for (int bj = 0; bj < 2; ++bj)
#pragma unroll
            for (int n = 0; n < 2; ++n) gg[bj][n] = *(const f32x4*)(gain + col0 + bj * HALF + 4 * n);
#pragma unroll
        for (int ai = 0; ai < 2; ++ai)
#pragma unroll
            for (int m = 0; m < 4; ++m) { const int row = row0 + ai * HALF + m * 16; float sq = 0.f;
#pragma unroll
                for (int bj = 0; bj < 2; ++bj) { f32x4 b0, b1; unpk(bh[ai][m][bj], b0, b1);
                    const f32x4 v0 = acc[ai][bj][m][0] + b0, v1 = acc[ai][bj][m][1] + b1;
                    sq += (v0[0] * v0[0] + v0[1] * v0[1]) + (v0[2] * v0[2] + v0[3] * v0[3]) + (v1[0] * v1[0] + v1[1] * v1[1]) + (v1[2] * v1[2] + v1[3] * v1[3]); }
                sq += __shfl_xor(sq, 16); sq += __shfl_xor(sq, 32);
                if (fq == 0) unsafeAtomicAdd(ss + row, sq); }
        asm volatile("s_waitcnt vmcnt(0)" ::: "memory");
        __syncthreads();
        if (wr == 0 && wc == 0 && fr == 0 && fq == 0) {
            unsigned* c = cnt + u.pm;
            (void)__hip_atomic_fetch_add(c, 1u, __ATOMIC_RELAXED, __HIP_MEMORY_SCOPE_AGENT);
            unsigned sp = 0u;
            while (__hip_atomic_load(c, __ATOMIC_RELAXED, __HIP_MEMORY_SCOPE_AGENT) < nown) { __builtin_amdgcn_s_sleep(1);
                if ((++sp & 255u) == 0u) { if (__hip_atomic_load(tmo, __ATOMIC_RELAXED, __HIP_MEMORY_SCOPE_AGENT)) break; if (sp > (1u << 18)) { atomicAdd(tmo, 1u); break; } } }
        }
        __syncthreads();
        const bool bad = __hip_atomic_load(tmo, __ATOMIC_RELAXED, __HIP_MEMORY_SCOPE_AGENT) != 0u;
        const float qnan = __builtin_nanf("");
        float ssv[2][4];
#pragma unroll
        for (int ai = 0; ai < 2; ++ai)
#pragma unroll
            for (int m = 0; m < 4; ++m) ssv[ai][m] = __hip_atomic_load(ss + row0 + ai * HALF + m * 16, __ATOMIC_RELAXED, __HIP_MEMORY_SCOPE_AGENT);
#pragma unroll
        for (int ai = 0; ai < 2; ++ai)
#pragma unroll
            for (int m = 0; m < 4; ++m) { const int row = row0 + ai * HALF + m * 16; const size_t off = (size_t)row * ldc + col0;
                const float rs = bad ? qnan : __builtin_amdgcn_rsqf(ssv[ai][m] * (1.0f / 4096.0f) + eps);
#pragma unroll
                for (int bj = 0; bj < 2; ++bj) { f32x4 b0, b1; unpk(bh[ai][m][bj], b0, b1);
                    const f32x4 v0 = (acc[ai][bj][m][0] + b0) * rs * gg[bj][0], v1 = (acc[ai][bj][m][1] + b1) * rs * gg[bj][1];
                    *(f32x4*)(out + off + bj * HALF) = v0; *(f32x4*)(out + off + bj * HALF + 4) = v1; } }
    }
};
}
namespace dattn {
#define DA_LAS __attribute__((address_space(3)))
typedef unsigned short bf16_t;
typedef short bf16x8 __attribute__((ext_vector_type(8)));
typedef short s16x4 __attribute__((ext_vector_type(4)));
typedef float f32x16 __attribute__((ext_vector_type(16)));
typedef float f32x4 __attribute__((ext_vector_type(4)));
typedef unsigned u32x4 __attribute__((ext_vector_type(4)));
constexpr int PITCH = 4096;
constexpr int STAGE = 65536, OFF_V = 32768;
constexpr int OFF_TBL = 131072, OFF_WS = OFF_TBL + 512, LDS_END = OFF_WS + 8 * 256;
constexpr float LOG2E = 1.4426950408889634f;
constexpr float THR = 8.0f;
constexpr float QSCALE = 0.08838834764831845f * LOG2E;

__device__ __forceinline__ int crow(int r, int hi) { return (r & 3) + 8 * (r >> 2) + 4 * hi; }
__device__ __forceinline__ unsigned cvtpk(float lo, float hi) { unsigned r; asm volatile("v_cvt_pk_bf16_f32 %0, %1, %2" : "=v"(r) : "v"(lo), "v"(hi)); return r; }
__device__ __forceinline__ int v_rd_base(int lane) { return ((lane & 3) << 3) | (((lane >> 2) & 3) << 6) | (((lane >> 4) & 1) << 5) | (((lane >> 5) & 1) << 8); }
__device__ __forceinline__ float silu(float z) { return z * __builtin_amdgcn_rcpf(1.0f + __builtin_amdgcn_exp2f(-LOG2E * z)); }

__device__ __forceinline__ int fresh_lane() { int l; asm volatile("v_mbcnt_lo_u32_b32 %0, -1, 0\n\tv_mbcnt_hi_u32_b32 %0, -1, %0" : "=v"(l)); return l; }
template <int M> __device__ __forceinline__ float swz_xor(float v) { return __int_as_float(__builtin_amdgcn_ds_swizzle(__float_as_int(v), (M << 10) | 0x1f)); }
struct Tensors { const bf16_t* Q; const bf16_t* K; const bf16_t* V; const bf16_t* Z; bf16_t* O; const float* rel_bias; const float* subln; };

#define DA_WAIT_BAR() asm volatile("s_waitcnt vmcnt(0) lgkmcnt(0)\n\ts_barrier" ::: "memory")
#define DA_SBAR() __builtin_amdgcn_sched_barrier(0)

template <int ST>
__device__ __forceinline__ void tile(DA_LAS unsigned char* lds, int tt, int qw, int r32, int hi, int kbase, int vb, const bf16x8 (&qr)[8], f32x16 (&o)[8], float& m_reg, float& l_reg,
                                     DA_LAS float* wsf, const DA_LAS float* tbl) {
    const int k0 = tt * 64;
    asm volatile("" : "+v"(kbase), "+v"(vb));
    f32x16 p0 = {}, p1 = {};
#pragma unroll
    for (int d0 = 0; d0 < 8; ++d0) { const int a = ST * STAGE + (kbase ^ (d0 << 5));
        const bf16x8 b0 = *(const DA_LAS bf16x8*)(lds + a), b1 = *(const DA_LAS bf16x8*)(lds + a + 8192);
        p0 = __builtin_amdgcn_mfma_f32_32x32x16_bf16(b0, qr[d0], p0, 0, 0, 0);
        p1 = __builtin_amdgcn_mfma_f32_32x32x16_bf16(b1, qr[d0], p1, 0, 0, 0); }
    if (k0 + 176 > qw) {
        const float NEG = -__builtin_inff(); const int dq = qw + r32 - k0 - 4 * hi;
#pragma unroll
        for (int r = 0; r < 16; ++r) { const int c = (r & 3) + 8 * (r >> 2); const int d_0 = dq - c, d_1 = d_0 - 32;
            const int i0 = d_0 < 0 ? 0 : (d_0 > 127 ? 127 : d_0), i1 = d_1 < 0 ? 0 : (d_1 > 127 ? 127 : d_1);
            const float b_0 = tbl[i0], b_1 = tbl[i1];
            p0[r] = d_0 < 0 ? NEG : p0[r] + b_0; p1[r] = d_1 < 0 ? NEG : p1[r] + b_1; }
    }
#define DA_MX3(a, b, c) __builtin_fmaxf(__builtin_fmaxf((a), (b)), (c))
    float pmA = DA_MX3(p0[0], p0[1], p0[2]), pmB = DA_MX3(p0[3], p0[4], p0[5]), pmC = DA_MX3(p1[0], p1[1], p1[2]), pmD = DA_MX3(p1[3], p1[4], p1[5]);
#pragma unroll
    for (int r = 6; r < 14; r += 4) { pmA = DA_MX3(pmA, p0[r], p0[r + 1]); pmB = DA_MX3(pmB, p0[r + 2], p0[r + 3]); pmC = DA_MX3(pmC, p1[r], p1[r + 1]); pmD = DA_MX3(pmD, p1[r + 2], p1[r + 3]); }
    pmA = DA_MX3(pmA, p0[14], p0[15]); pmC = DA_MX3(pmC, p1[14], p1[15]);
    float pmax = fmaxf(DA_MX3(pmA, pmB, pmC), pmD);
#undef DA_MX3
    { auto rr = __builtin_amdgcn_permlane32_swap(__float_as_uint(pmax), __float_as_uint(pmax), false, false); pmax = fmaxf(__uint_as_float(rr[0]), __uint_as_float(rr[1])); }
    if (!__all(pmax - m_reg <= THR)) {
        const float mn = fmaxf(m_reg, pmax); const float alpha = __builtin_amdgcn_exp2f(m_reg - mn); m_reg = mn; l_reg *= alpha;
        if (hi == 0) wsf[r32] = alpha;
        asm volatile("s_waitcnt lgkmcnt(0)" ::: "memory");
        float al[16];
#pragma unroll
        for (int r = 0; r < 16; ++r) al[r] = wsf[crow(r, hi)];
#pragma unroll
        for (int d0 = 0; d0 < 8; ++d0)
#pragma unroll
            for (int r = 0; r < 16; ++r) o[d0][r] *= al[r];
    }
    float ps = 0.f;
#pragma unroll
    for (int r = 0; r < 16; ++r) { p0[r] = __builtin_amdgcn_exp2f(p0[r] - m_reg); ps += p0[r]; }
#pragma unroll
    for (int r = 0; r < 16; ++r) { p1[r] = __builtin_amdgcn_exp2f(p1[r] - m_reg); ps += p1[r]; }
    l_reg += ps;
    bf16x8 pa0, pa1, pa2, pa3;
#define DA_PK4(P, B_, OUT) do { const unsigned a0 = cvtpk(P[B_ + 0], P[B_ + 1]), a1 = cvtpk(P[B_ + 2], P[B_ + 3]); \
        const unsigned b0 = cvtpk(P[B_ + 4], P[B_ + 5]), b1 = cvtpk(P[B_ + 6], P[B_ + 7]); \
        auto r0 = __builtin_amdgcn_permlane32_swap(a0, b0, false, false); auto r1 = __builtin_amdgcn_permlane32_swap(a1, b1, false, false); \
        u32x4 w = {r0[0], r1[0], r0[1], r1[1]}; OUT = __builtin_bit_cast(bf16x8, w); } while (0)
    DA_PK4(p0, 0, pa0); DA_PK4(p0, 8, pa1); DA_PK4(p1, 0, pa2); DA_PK4(p1, 8, pa3);
#undef DA_PK4
    const int vbs = vb + ST * STAGE;
#define DA_TRRD(dst, off) asm volatile("ds_read_b64_tr_b16 %0, %1 offset:%2" : "=&v"(dst) : "v"(vbs), "i"(off) : "memory")
#define DA_PV(d0) do { s16x4 l0, l1, l2, l3, h0, h1, h2, h3; constexpr int b_ = (d0) * 512; \
        DA_TRRD(l0, b_); DA_TRRD(h0, b_ + 4096); DA_TRRD(l1, b_ + 8192); DA_TRRD(h1, b_ + 12288); DA_TRRD(l2, b_ + 16384); DA_TRRD(h2, b_ + 20480); DA_TRRD(l3, b_ + 24576); DA_TRRD(h3, b_ + 28672); \
        asm volatile("s_waitcnt lgkmcnt(0)" ::: "memory"); DA_SBAR(); \
        o[d0] = __builtin_amdgcn_mfma_f32_32x32x16_bf16(pa0, (bf16x8){l0[0], l0[1], l0[2], l0[3], h0[0], h0[1], h0[2], h0[3]}, o[d0], 0, 0, 0); \
        o[d0] = __builtin_amdgcn_mfma_f32_32x32x16_bf16(pa1, (bf16x8){l1[0], l1[1], l1[2], l1[3], h1[0], h1[1], h1[2], h1[3]}, o[d0], 0, 0, 0); \
        o[d0] = __builtin_amdgcn_mfma_f32_32x32x16_bf16(pa2, (bf16x8){l2[0], l2[1], l2[2], l2[3], h2[0], h2[1], h2[2], h2[3]}, o[d0], 0, 0, 0); \
        o[d0] = __builtin_amdgcn_mfma_f32_32x32x16_bf16(pa3, (bf16x8){l3[0], l3[1], l3[2], l3[3], h3[0], h3[1], h3[2], h3[3]}, o[d0], 0, 0, 0); } while (0)
    DA_PV(0); DA_PV(1); DA_PV(2); DA_PV(3); DA_PV(4); DA_PV(5); DA_PV(6); DA_PV(7);
#undef DA_PV
#undef DA_TRRD
}

__device__ __forceinline__ void attn_unit(int h, int qb, const Tensors& T, float lam, DA_LAS unsigned char* lds, int wid) {
    const int lane = fresh_lane(), tid = wid * 64 + lane, r32 = lane & 31, hi = lane >> 5;
    const int rb = wid & 3, sh = wid >> 2;
    const int q0 = qb * 128, qw = q0 + rb * 32;
    const int NT = 2 * (qb + 1);
    const int ntw = (qw + 31) / 64 + 1;
    DA_LAS float* tbl = (DA_LAS float*)(lds + OFF_TBL);
    DA_LAS float* wsf = (DA_LAS float*)(lds + OFF_WS) + wid * 64;
    if (tid < 128) {
        const int n = tid; int bucket = n;
        if (n >= 16) { const float v = logf((float)n / 16.0f) / 2.0794415416798357f * 16.0f; const int lg = 16 + (int)v; bucket = lg < 31 ? lg : 31; }
        tbl[n] = (T.rel_bias[bucket * 16 + h] - T.rel_bias[31 * 16 + h]) * LOG2E;
    }
    const bool isK = wid < 4; const int wv = wid - 4;
    const unsigned laneK = (unsigned)((lane >> 4) * 8192 + (((lane & 15) ^ (lane >> 4)) << 4));
    const unsigned laneV = (unsigned)((8 * ((lane >> 4) & 1) + ((lane >> 2) & 3)) * 8192 + (lane >> 5) * 64 + (lane & 3) * 16);
    const unsigned laneoff = isK ? laneK : laneV;
    const bf16_t* gplane = isK ? T.K : T.V;
    const unsigned goff = (unsigned)h * 512u + (isK ? (unsigned)(wid >> 1) * 256u + (unsigned)((wid & 1) * 32) * 8192u : (unsigned)(16 * wv) * 8192u);
    const int dst0 = isK ? (wid >> 1) * 16384 + (wid & 1) * 8192 : OFF_V + wv * 8192;
#define DA_DMA(t_, st_) do { _Pragma("unroll") for (int i_ = 0; i_ < 8; ++i_) { \
        const unsigned uo_ = goff + (unsigned)(t_) * (64u * 8192u) + (isK ? (unsigned)(i_ * 32768) : (unsigned)((i_ >> 2) * 32768 + (i_ & 3) * 128)); \
        const unsigned lo_ = (laneoff ^ (isK ? (unsigned)((i_ & 3) << 6) : 0u)) + uo_; \
        const unsigned ld_ = (unsigned)(uintptr_t)lds + (unsigned)((st_) * STAGE + dst0 + i_ * 1024); unsigned keep_; \
        asm volatile("s_mov_b32 %0, m0\n\ts_mov_b32 m0, %3\n\ts_nop 0\n\tglobal_load_lds_dwordx4 %1, %2\n\ts_mov_b32 m0, %0" : "=&s"(keep_) : "v"(lo_), "s"(gplane), "s"(ld_) : "memory"); } } while (0)
    DA_DMA(0, 0);
    const bf16_t* Qw = T.Q + (size_t)(qw + r32) * PITCH + h * 256 + sh * 128 + hi * 8;
    bf16x8 qr[8];
#pragma unroll
    for (int d0 = 0; d0 < 8; ++d0) qr[d0] = *(const bf16x8*)(Qw + d0 * 16);
    const int kbase = sh * 16384 + r32 * 256 + (((r32 & 15) ^ hi) << 4);
    const int vb = (int)(uintptr_t)lds + OFF_V + v_rd_base(lane);
    float m_reg = -1e30f, l_reg = 0.f;
    f32x16 o[8];
#pragma unroll
    for (int d0 = 0; d0 < 8; ++d0) o[d0] = f32x16{};
    for (int t = 0; t < NT; t += 2) {
        DA_WAIT_BAR();
        DA_DMA(t + 1, 1);
        if (t < ntw) tile<0>(lds, t, qw, r32, hi, kbase, vb, qr, o, m_reg, l_reg, wsf, tbl);
        DA_WAIT_BAR();
        if (t + 2 < NT) DA_DMA(t + 2, 0);
        if (t + 1 < ntw) tile<1>(lds, t + 1, qw, r32, hi, kbase, vb, qr, o, m_reg, l_reg, wsf, tbl);
    }
#undef DA_DMA
    { auto rr = __builtin_amdgcn_permlane32_swap(__float_as_uint(l_reg), __float_as_uint(l_reg), false, false); l_reg = __uint_as_float(rr[0]) + __uint_as_float(rr[1]); }
    if (hi == 0) wsf[r32] = 1.0f / l_reg;
    asm volatile("s_waitcnt lgkmcnt(0)" ::: "memory");
    float rli[16];
#pragma unroll
    for (int r = 0; r < 16; ++r) rli[r] = wsf[crow(r, hi)];
#pragma unroll
    for (int d0 = 0; d0 < 8; ++d0)
#pragma unroll
        for (int r = 0; r < 16; ++r) o[d0][r] *= rli[r];
    DA_WAIT_BAR();
    DA_LAS f32x4* X4 = (DA_LAS f32x4*)(lds + rb * 32768);
    if (sh == 1) { const float nl = -lam;
#pragma unroll
        for (int d0 = 0; d0 < 8; ++d0) {
#pragma unroll
            for (int j = 0; j < 4; ++j) { f32x4 v; v[0] = o[d0][4 * j] * nl; v[1] = o[d0][4 * j + 1] * nl; v[2] = o[d0][4 * j + 2] * nl; v[3] = o[d0][4 * j + 3] * nl;
                X4[(d0 * 4 + j) * 64 + lane] = v; }
            DA_SBAR(); }
    }
    DA_WAIT_BAR();
    u32x4 zq[8];
#pragma unroll
    for (int p_ = 0; p_ < 8; ++p_) zq[p_] = *(const u32x4*)(T.Z + (size_t)(qw + 2 * (p_ + 8 * sh) + hi) * PITCH + h * 256 + r32 * 8);
    if (sh == 0) {
#pragma unroll
        for (int d0 = 0; d0 < 8; ++d0)
#pragma unroll
            for (int j = 0; j < 4; ++j) { const f32x4 v = X4[(d0 * 4 + j) * 64 + lane]; o[d0][4 * j] += v[0]; o[d0][4 * j + 1] += v[1]; o[d0][4 * j + 2] += v[2]; o[d0][4 * j + 3] += v[3]; if (j == 3) DA_SBAR(); }
        float rs[16];
#pragma unroll
        for (int r = 0; r < 16; ++r) { float s = 0.f;
#pragma unroll
            for (int d0 = 0; d0 < 8; ++d0) s += o[d0][r] * o[d0][r];
            s += swz_xor<1>(s); s += swz_xor<2>(s); s += swz_xor<4>(s); s += swz_xor<8>(s); s += swz_xor<16>(s);
            rs[r] = 0.8f * __builtin_amdgcn_rsqf(s * (1.0f / 256.0f) + 1e-5f); }
        float gn[8];
#pragma unroll
        for (int d0 = 0; d0 < 8; ++d0) gn[d0] = T.subln[d0 * 32 + r32];
        asm volatile("s_waitcnt lgkmcnt(0)" ::: "memory");
        DA_LAS float* Y = (DA_LAS float*)(lds + rb * 32768);
#pragma unroll
        for (int d0 = 0; d0 < 8; ++d0)
#pragma unroll
            for (int r = 0; r < 16; ++r) Y[crow(r, hi) * 256 + d0 * 32 + r32] = o[d0][r] * rs[r] * gn[d0];
    }
    DA_WAIT_BAR();
    {
        const DA_LAS float* Y = (const DA_LAS float*)(lds + rb * 32768);
#pragma unroll
        for (int p_ = 0; p_ < 8; ++p_) { const int row = 2 * (p_ + 8 * sh) + hi;
            const DA_LAS f32x4* yp = (const DA_LAS f32x4*)(Y + row * 256 + r32 * 8); const f32x4 y0 = yp[0], y1 = yp[1];
            const size_t go = (size_t)(qw + row) * PITCH + h * 256 + r32 * 8;
            const u32x4 zz = zq[p_];
            u32x4 w;
            w.x = cvtpk(y0[0] * silu(__uint_as_float(zz.x << 16)), y0[1] * silu(__uint_as_float(zz.x & 0xffff0000u)));
            w.y = cvtpk(y0[2] * silu(__uint_as_float(zz.y << 16)), y0[3] * silu(__uint_as_float(zz.y & 0xffff0000u)));
            w.z = cvtpk(y1[0] * silu(__uint_as_float(zz.z << 16)), y1[1] * silu(__uint_as_float(zz.z & 0xffff0000u)));
            w.w = cvtpk(y1[2] * silu(__uint_as_float(zz.w << 16)), y1[3] * silu(__uint_as_float(zz.w & 0xffff0000u)));
            *(u32x4*)(T.O + go) = w; }
    }
    DA_WAIT_BAR();
}

__device__ __forceinline__ void attn_phase(DA_LAS unsigned char* lds, const Tensors& T, const float* lamp, int vcu, int G, int wid) {
    const int lane = fresh_lane();
    float s1 = lamp[lane] * lamp[128 + lane] + lamp[64 + lane] * lamp[192 + lane];
    float s2 = lamp[256 + lane] * lamp[384 + lane] + lamp[320 + lane] * lamp[448 + lane];
#pragma unroll
    for (int o_ = 1; o_ < 64; o_ <<= 1) { s1 += __shfl_xor(s1, o_); s2 += __shfl_xor(s2, o_); }
    const float lam = __int_as_float(__builtin_amdgcn_readfirstlane(__float_as_int(expf(s1) - expf(s2) + 0.2f)));
    const int nit = (G == 256) ? 4 : (vcu < 1024 ? (1024 - vcu + G - 1) / G : 0);
    for (int u = 0; u < 2 * nit; ++u) {
        const int i = u >> 1; int h, pi;
        if (G == 256) { h = 2 * (vcu >> 5) + (i >> 1); pi = (i & 1) * 32 + (vcu & 31); }
        else { const int p = vcu + i * G; h = p >> 6; pi = p & 63; }
        attn_unit(h, (u & 1) ? pi : 127 - pi, T, lam, lds, wid);
    }
}
#undef DA_WAIT_BAR
#undef DA_SBAR
}
#define GAS __attribute__((address_space(1)))
#define LAS __attribute__((address_space(3)))
typedef unsigned short bf16;
typedef unsigned v4u __attribute__((ext_vector_type(4)));
typedef float f32x4 __attribute__((ext_vector_type(4)));
typedef short bf16x8 __attribute__((ext_vector_type(8)));
typedef GAS unsigned gu32;
typedef GAS unsigned long long gu64;
#define RLX_AGENT __ATOMIC_RELAXED, __HIP_MEMORY_SCOPE_AGENT
#define LDS_WAIT() asm volatile("s_waitcnt lgkmcnt(0)" ::: "memory")
#define VM_WAIT() asm volatile("s_waitcnt vmcnt(0)" ::: "memory")
__device__ __forceinline__ unsigned long long rt() { return __builtin_amdgcn_s_memrealtime(); }
__device__ __forceinline__ unsigned f2bf(float f) { unsigned u = __builtin_bit_cast(unsigned, f); return (u + 0x7fffu + ((u >> 16) & 1u)) >> 16; }
__device__ __forceinline__ unsigned pk2(float lo, float hi) { unsigned r; asm("v_cvt_pk_bf16_f32 %0, %1, %2" : "=v"(r) : "v"(lo), "v"(hi)); return r; }

#define XB_TMO      128
#define XB_XCNT(j)  (256  + 64 * (j))
#define XB_XSUB(j)  (1280 + 64 * (j))
#define XB_XGEN(j)  (2304 + 64 * (j))
#define XB_TOP      3328
#define XB_TOPGEN   3392
#define XCD_BAR_WORDS 3456
#define XB_SPIN_CAP (1u << 18)

__device__ __forceinline__ unsigned xb_ld(unsigned* p)              { return __hip_atomic_load(p, __ATOMIC_RELAXED, __HIP_MEMORY_SCOPE_AGENT); }
__device__ __forceinline__ unsigned xb_add(unsigned* p, unsigned v) { return __hip_atomic_fetch_add(p, v, __ATOMIC_RELAXED, __HIP_MEMORY_SCOPE_AGENT); }
__device__ __forceinline__ unsigned xb_xcc_id() { return (unsigned)__builtin_amdgcn_s_getreg((3 << 11) | 20) & 0xFu; }
#define XB_SPIN(cond, bar) do { unsigned _sp = 0; while (cond) { __builtin_amdgcn_s_sleep(1); \
    if ((++_sp & 255u) == 0u) { if (xb_ld(&(bar)[XB_TMO])) break; if (_sp > XB_SPIN_CAP) { atomicAdd(&(bar)[XB_TMO], 1u); break; } } } } while (0)

struct XcdBarrier {
    unsigned* bar; unsigned x;
    volatile LAS unsigned* st;
};

__device__ __forceinline__ XcdBarrier xcd_barrier_post(unsigned* bar, volatile LAS unsigned* st) {
    XcdBarrier b; b.bar = bar; b.x = xb_xcc_id(); b.st = st;
    if (threadIdx.x == 0) (void)xb_add(&bar[XB_XCNT(b.x)], 1u);
    return b;
}
__device__ __forceinline__ void xcd_barrier_complete(unsigned* bar, unsigned x, unsigned& nloc, unsigned& nx) {
    const unsigned G = gridDim.x * gridDim.y * gridDim.z;
    unsigned sum, cnt, mine, sp = 0u;
    for (;;) {
        sum = 0u; cnt = 0u; mine = 0u;
#pragma unroll
        for (unsigned j = 0; j < 16; ++j) { const unsigned c = xb_ld(&bar[XB_XCNT(j)]); sum += c; cnt += (c > 0u) ? 1u : 0u; mine = (j == x) ? c : mine; }
        if (sum == G) break;
        __builtin_amdgcn_s_sleep(1);
        if ((++sp & 255u) == 0u) { if (xb_ld(&bar[XB_TMO])) break; if (sp > XB_SPIN_CAP) { atomicAdd(&bar[XB_TMO], 1u); break; } }
    }
    nloc = mine > 0u ? mine : 1u; nx = cnt > 0u ? cnt : 1u;
}

__device__ __forceinline__ void xcd_barrier(const XcdBarrier& b, const int wave_) {
    asm volatile("s_waitcnt vmcnt(0)" ::: "memory");
    __syncthreads();
    int lane_; asm volatile("v_mbcnt_lo_u32_b32 %0, -1, 0\n\tv_mbcnt_hi_u32_b32 %0, -1, %0" : "=v"(lane_));
    if (wave_ == 0 && lane_ == 0) {
        unsigned* bar = b.bar;
        __builtin_amdgcn_s_waitcnt(0);
        unsigned nloc = b.st[0], nx = b.st[1];
        if (nloc == 0u) { xcd_barrier_complete(bar, b.x, nloc, nx); b.st[0] = nloc; b.st[1] = nx; }
        const unsigned old = xb_add(&bar[XB_XSUB(b.x)], 1u);
        const unsigned gen = old / nloc;
        if (old + 1u == (gen + 1u) * nloc) {
            __builtin_amdgcn_fence(__ATOMIC_RELEASE, "agent");
            asm volatile("s_waitcnt vmcnt(0)" ::: "memory");
            const unsigned og = xb_add(&bar[XB_TOP], 1u);
            const unsigned tg = og / nx;
            if (og + 1u == (tg + 1u) * nx) xb_add(&bar[XB_TOPGEN], 1u);
            else XB_SPIN(xb_ld(&bar[XB_TOPGEN]) == tg, bar);
            __builtin_amdgcn_fence(__ATOMIC_ACQUIRE, "agent");
            xb_add(&bar[XB_XGEN(b.x)], 1u);
            asm volatile("s_waitcnt vmcnt(0)" ::: "memory");
        } else {
            XB_SPIN(xb_ld(&bar[XB_XGEN(b.x)]) == gen, bar);
            __builtin_amdgcn_fence(__ATOMIC_ACQUIRE, "agent");
            asm volatile("s_waitcnt vmcnt(0)" ::: "memory");
        }
    }
    __syncthreads();
}
constexpr int NWAVES = 8;
constexpr int SEQ = 16384, DM = 4096, NH = 16, AW = 4096, PW = 8192, PGD = 2048;
constexpr float NORM_EPS = 1e-6f;
#ifndef MK_N_LAUNCHES
#define MK_N_LAUNCHES 1
#endif
constexpr int N_PHASES = 9;

constexpr size_t MiB = 1u << 20;
constexpr size_t WS_CTL = 0, CTL_ZERO_BYTES = 256 * 1024;
constexpr size_t WS_SS1 = 64 * 1024, WS_SS2 = 128 * 1024;
constexpr size_t WS_SS0 = 256 * 1024;
constexpr size_t WS_WO1 = 2 * MiB, WS_WG = 34 * MiB, WS_WO2 = 66 * MiB, WS_W2 = 130 * MiB;
constexpr size_t WS_Q = 258 * MiB, WS_K = 386 * MiB, WS_V = 514 * MiB, WS_Z = 642 * MiB, WS_O = 770 * MiB;
constexpr size_t WS_YF = 386 * MiB, WS_YL = 418 * MiB;
constexpr size_t WS_Z2 = 642 * MiB;
constexpr size_t WS_WINU = 898 * MiB;
constexpr size_t WS_END = 962 * MiB;
constexpr size_t OUT_W1 = 0, OUT_XB = 128 * MiB;
constexpr int CW_TMO = 0, CW_BAR = 4096, CW_PANEL = 8192;

constexpr int RING_BYTES = 131072;
constexpr int LDS_BYTES = 163840;
constexpr int MISC_OFF = LDS_BYTES - 256;
static_assert(dattn::LDS_END <= MISC_OFF && 8 * 64 * 65 * 4 <= MISC_OFF, "LDS map");

__device__ __forceinline__ float wave_sum(float v) {
#pragma unroll
    for (int o = 1; o < 64; o <<= 1) v += __shfl_xor(v, o);
    return v;
}
__device__ __forceinline__ void transpose_item(const float* W, int N, int nblk, bf16* WT, int ldt, const float* gain, LAS float* scr, int item, int lane) {
    const int kb = item / nblk, nb = item - kb * nblk, k0 = kb * 64, n0 = nb * 64;
    const int lr = lane >> 4, lc = (lane & 15) * 4;
    f32x4 ld[16];
#pragma unroll
    for (int i = 0; i < 16; ++i) ld[i] = *(const f32x4*)(W + (size_t)(k0 + 4 * i + lr) * N + n0 + lc);
#pragma unroll
    for (int i = 0; i < 16; ++i) { const int kk = 4 * i + lr; f32x4 v = ld[i];
        if (gain) { const float g = gain[k0 + kk]; v = v * g; }
        LAS float* s = scr + kk * 65 + lc; s[0] = v[0]; s[1] = v[1]; s[2] = v[2]; s[3] = v[3]; }
    LDS_WAIT(); asm volatile("" ::: "memory");
    const int c = lane & 7;
#pragma unroll 2
    for (int j = 0; j < 8; ++j) { const int n = (lane >> 3) + 8 * j; const LAS float* s = scr + (8 * c) * 65 + n;
        v4u o; o.x = pk2(s[0 * 65], s[1 * 65]); o.y = pk2(s[2 * 65], s[3 * 65]); o.z = pk2(s[4 * 65], s[5 * 65]); o.w = pk2(s[6 * 65], s[7 * 65]);
        *(v4u*)(WT + (size_t)(n0 + n) * ldt + k0 + 8 * c) = o; }
    LDS_WAIT(); asm volatile("" ::: "memory");
}

__device__ __forceinline__ void unpack8(const v4u q, float (&f)[8]) {
    f[0] = __uint_as_float(q.x << 16); f[1] = __uint_as_float(q.x & 0xffff0000u); f[2] = __uint_as_float(q.y << 16); f[3] = __uint_as_float(q.y & 0xffff0000u);
    f[4] = __uint_as_float(q.z << 16); f[5] = __uint_as_float(q.z & 0xffff0000u); f[6] = __uint_as_float(q.w << 16); f[7] = __uint_as_float(q.w & 0xffff0000u); }
struct Args { const float* in[12]; float* out; unsigned char* ws; int ph_lo, ph_hi; };

__global__ void __launch_bounds__(NWAVES * 64, 2) hybrid_fwd(Args args) {
    extern __shared__ __attribute__((aligned(16))) unsigned char lds_raw[];
    LAS unsigned char* lds = (LAS unsigned char*)lds_raw;
    volatile LAS unsigned* MISC = (volatile LAS unsigned*)(lds + MISC_OFF);
    const int tid0 = threadIdx.x, wave = __builtin_amdgcn_readfirstlane(tid0 >> 6);
    const int G = gridDim.x; const int bx = blockIdx.x; const int vcu = (G % 8 == 0) ? (bx % 8) * (G / 8) + bx / 8 : bx;
    unsigned char* ws = args.ws; unsigned char* outb = (unsigned char*)args.out;
    const float* x = args.in[0]; const float* norm_gains = args.in[1]; const float* final_gain = args.in[2]; const float* rel_bias = args.in[3];
    const float* attn_w_in = args.in[4]; const float* attn_lambda = args.in[5]; const float* attn_subln = args.in[6]; const float* attn_w_out = args.in[7];
    const float* pool_w_in = args.in[8]; const float* pool_w_group = args.in[9]; const float* pool_scale = args.in[10]; const float* pool_w_out = args.in[11];
    unsigned* ctl = (unsigned*)(ws + WS_CTL);
    float* ss0 = (float*)(ws + WS_SS0); float* ss1 = (float*)(ws + WS_SS1); float* ss2 = (float*)(ws + WS_SS2);
    bf16* W1t = (bf16*)(outb + OUT_W1); bf16* XB = (bf16*)(outb + OUT_XB);
    bf16* Wo1t = (bf16*)(ws + WS_WO1); bf16* Wgt = (bf16*)(ws + WS_WG); bf16* Wo2t = (bf16*)(ws + WS_WO2); bf16* W2t = (bf16*)(ws + WS_W2);
    bf16* Qp = (bf16*)(ws + WS_Q); bf16* Kp = (bf16*)(ws + WS_K); bf16* Vp = (bf16*)(ws + WS_V); bf16* Zp = (bf16*)(ws + WS_Z); bf16* Op = (bf16*)(ws + WS_O);
    bf16* WinU = (bf16*)(ws + WS_WINU);
    bf16* XB1 = Qp; bf16* Z2p = (bf16*)(ws + WS_Z2);
    float* xres = args.out;

    if (tid0 < 64) ((LAS unsigned*)(lds + MISC_OFF))[tid0] = 0u;
    __syncthreads();
    XcdBarrier bar; bar.bar = ctl + CW_BAR; bar.x = 0; bar.st = nullptr;
    if (MK_N_LAUNCHES == 1) bar = xcd_barrier_post(ctl + CW_BAR, MISC);
    const int lo = args.ph_lo, hi = args.ph_hi;
#define IN(k) (lo <= (k) && (k) < hi)
#define GRID_BAR(k) do { if (IN((k) + 1)) xcd_barrier(bar, wave); } while (0)

    if (IN(0)) {
        const int lane = dattn::fresh_lane();
        LAS float* scr = (LAS float*)lds + wave * (64 * 65);
        const int gw = vcu * NWAVES + wave, NGW = G * NWAVES;
        constexpr int I_W1 = (DM / 64) * (4 * AW / 64), I_WO1 = (AW / 64) * (DM / 64), I_W2Z = (DM / 64) * (PW / 64), I_WG = (PGD / 64) * (PGD / 64), I_WO2 = (PW / 64) * (DM / 64);
        constexpr int NITEMS = I_W1 + I_WO1 + I_W2Z + 4 * I_WG + I_WO2;
        for (int it = gw; it < NITEMS; it += NGW) {
            int r = it;
            if (r < I_W1) { transpose_item(attn_w_in, 4 * AW, 4 * AW / 64, W1t, DM, norm_gains, scr, r, lane); continue; } r -= I_W1;
            if (r < I_WO1) { transpose_item(attn_w_out, DM, DM / 64, Wo1t, AW, nullptr, scr, r, lane); continue; } r -= I_WO1;
            if (r < I_W2Z) { const int n0 = (r % (PW / 64)) * 64;
                transpose_item(pool_w_in + PW, 2 * PW, PW / 64, W2t + (size_t)((n0 >> 7) * 128 + 128) * DM, DM, norm_gains + DM, scr, r, lane); continue; } r -= I_W2Z;
            if (r < 4 * I_WG) { const int g = r / I_WG; transpose_item(pool_w_group + (size_t)g * PGD * PGD, PGD, PGD / 64, Wgt + (size_t)g * PGD * PGD, PGD, nullptr, scr, r - g * I_WG, lane); continue; } r -= 4 * I_WG;
            transpose_item(pool_w_out, DM, DM / 64, Wo2t, PW, nullptr, scr, r, lane);
        }
        {
            const int gt0 = gw * 64 + lane, NT0 = NGW * 64;
            for (int i0 = gt0; i0 < DM * (PW / 8); i0 += 4 * NT0) {
                f32x4 a[4], b4[4];
#pragma unroll
                for (int u = 0; u < 4; ++u) { const int i = i0 + u * NT0; if (i < DM * (PW / 8)) { const int k = i >> 10, c8 = (i & 1023) * 8;
                    a[u] = *(const f32x4*)(pool_w_in + (size_t)k * (2 * PW) + c8); b4[u] = *(const f32x4*)(pool_w_in + (size_t)k * (2 * PW) + c8 + 4); } }
#pragma unroll
                for (int u = 0; u < 4; ++u) { const int i = i0 + u * NT0; if (i < DM * (PW / 8)) { const int k = i >> 10, c8 = (i & 1023) * 8; const float gk = norm_gains[DM + k];
                    v4u o; o.x = pk2(a[u][0] * gk, a[u][1] * gk); o.y = pk2(a[u][2] * gk, a[u][3] * gk); o.z = pk2(b4[u][0] * gk, b4[u][1] * gk); o.w = pk2(b4[u][2] * gk, b4[u][3] * gk);
                    *(v4u*)(WinU + (size_t)k * PW + c8) = o; } } }
        }
        for (int m = gw; m < SEQ; m += NGW) {
            const f32x4* xr = (const f32x4*)(x + (size_t)m * DM) + lane; unsigned long long* o8 = (unsigned long long*)(XB + (size_t)m * DM) + lane; float s = 0.f;
            f32x4 xv[16];
#pragma unroll
            for (int j = 0; j < 16; ++j) xv[j] = xr[64 * j];
#pragma unroll
            for (int j = 0; j < 16; ++j) { const f32x4 v = xv[j]; s += (v[0] * v[0] + v[1] * v[1]) + (v[2] * v[2] + v[3] * v[3]);
                o8[64 * j] = (unsigned long long)pk2(v[0], v[1]) | ((unsigned long long)pk2(v[2], v[3]) << 32); }
            s = wave_sum(s); if (lane == 0) ss0[m] = s;
        }
        GRID_BAR(0);
    }
    if (IN(1)) {
        pg8::Gemm g{Wgt, WinU, PW, DM, PGD, PGD, PW, -1, 0, 3, PGD * 2}; pg8::StaticOrder S; S.init(PW, DM, G, bx);
        pg8::EpiPlain E{W2t, DM, 1};
        pg8::gemm_phase<pg8::EpiPlain, pg8::StaticOrder, true, true>(lds, g, S, E, wave);
    }
    if (IN(2)) {
        pg8::Gemm g{XB, W1t, SEQ, 4 * AW, DM, DM, DM, -1, 0, -1, 0}; pg8::StaticOrder S; S.init(SEQ, 4 * AW, G, bx);
        pg8::EpiNormSplit E{Qp, ss0, AW, (size_t)(WS_K - WS_Q) / 2, dattn::QSCALE, NORM_EPS, -1, 1.0f};
        pg8::gemm_phase<pg8::EpiNormSplit, pg8::StaticOrder, true, true>(lds, g, S, E, wave);
        GRID_BAR(2);
    }
    if (IN(3)) {
        const dattn::Tensors T{Qp, Kp, Vp, Zp, Op, rel_bias, attn_subln};
        dattn::attn_phase(lds, T, attn_lambda, vcu, G, wave);
        GRID_BAR(3);
    }
    if (IN(4)) {
        pg8::Gemm g{Op, Wo1t, SEQ, DM, AW, AW, AW, -1, 0, -1, 0};
        pg8::EpiResid<true, false, true> E{x, nullptr, nullptr, XB1, ss1, DM};
        { pg8::StaticOrder S; S.init(SEQ, DM, G, bx); pg8::gemm_phase<pg8::EpiResid<true, false, true>, pg8::StaticOrder, true, true>(lds, g, S, E, wave); }
        GRID_BAR(4);
    }
    bf16* MZp = (bf16*)(ws + WS_Z2); bf16* Yf = (bf16*)(ws + WS_YF); bf16* Yl = (bf16*)(ws + WS_YL);
    if (IN(5)) {
        pg8::Gemm g{XB1, W2t, SEQ, 2 * PW, DM, DM, DM, -1, 0, -1, 0}; pg8::StaticOrder S; S.init(SEQ, 2 * PW, G, bx);
        pg8::EpiPool E{MZp, Yf, Yl, ss1, pool_scale, lds + RING_BYTES, NORM_EPS};
        pg8::gemm_phase<pg8::EpiPool, pg8::StaticOrder, true, true>(lds, g, S, E, wave);
        GRID_BAR(5);
    }
    if (IN(6)) {
        const int gt = vcu * (NWAVES * 64) + wave * 64 + dattn::fresh_lane(), NT_ = G * NWAVES * 64;
        for (int task = gt; task < (SEQ / 256) * (PW / 8); task += NT_) {
            const int cc = task & 1023, pm = __builtin_amdgcn_readfirstlane(task >> 10), w = 2 << __builtin_amdgcn_readfirstlane(cc >> 8);
            const bf16* yp = Yl + ((size_t)(pm - 1) * 16) * PW + (size_t)cc * 8; const bf16* yc = Yf + ((size_t)pm * 16) * PW + (size_t)cc * 8; bf16* mz = MZp + ((size_t)pm * 256) * PW + (size_t)cc * 8;
            const f32x4 sc0 = *(const f32x4*)(pool_scale + cc * 8), sc1 = *(const f32x4*)(pool_scale + cc * 8 + 4);
            float scv[8], s[8];
#pragma unroll
            for (int e = 0; e < 8; ++e) { scv[e] = (e < 4 ? sc0[e] : sc1[e - 4]) * 0.6931471805599453f; s[e] = 0.f; }
            for (int r = 16 - w + 1; r < 16; ++r) if (pm > 0) { float f[8]; unpack8(*(const v4u*)(yp + (size_t)r * PW), f);
#pragma unroll
                for (int e = 0; e < 8; ++e) s[e] += f[e]; }
            for (int r = 0; r < 16; ++r) {
                float u[8], o_[8], z[8], a[8]; unpack8(*(const v4u*)(yc + (size_t)r * PW), u); unpack8(*(const v4u*)(mz + (size_t)r * PW), z);
#pragma unroll
                for (int e = 0; e < 8; ++e) { s[e] += u[e]; o_[e] = 0.f; }
                const int cnt = (pm == 0 && r + 1 < w) ? r + 1 : w; const float ic = 1.0f / (float)cnt;
#pragma unroll
                for (int e = 0; e < 8; ++e) a[e] = (s[e] * ic - u[e]) * scv[e] * (z[e] * __builtin_amdgcn_rcpf(1.0f + __builtin_amdgcn_exp2f(-z[e])));
                v4u o; o.x = pk2(a[0], a[1]); o.y = pk2(a[2], a[3]); o.z = pk2(a[4], a[5]); o.w = pk2(a[6], a[7]);
                *(v4u*)(mz + (size_t)r * PW) = o;
                const int ro = r + 1 - w;
                if (ro >= 0) unpack8(*(const v4u*)(yc + (size_t)ro * PW), o_); else if (pm > 0) unpack8(*(const v4u*)(yp + (size_t)(16 + ro) * PW), o_);
#pragma unroll
                for (int e = 0; e < 8; ++e) s[e] -= o_[e];
            }
        }
        GRID_BAR(6);
    }
    const bool fused_tail = (MK_N_LAUNCHES == 1) && (G % (DM / 256) == 0);
    if (IN(7)) {
        pg8::Gemm g{Z2p, Wo2t, SEQ, DM, PW, PW, PW, -1, 0, -1, 0};
        if (fused_tail) {
            pg8::PanelOrder S; S.init(SEQ, DM, G, vcu);
            pg8::EpiFinal E{XB1, xres, ss2, ctl + CW_PANEL, ctl + CW_BAR + XB_TMO, final_gain, DM, NORM_EPS, (unsigned)(DM / 256)};
            pg8::gemm_phase<pg8::EpiFinal, pg8::PanelOrder, true, true>(lds, g, S, E, wave);
        } else {
            pg8::StaticOrder S; S.init(SEQ, DM, G, bx);
            pg8::EpiResid<false, true, false> E{nullptr, XB1, xres, nullptr, ss2, DM};
            pg8::gemm_phase<pg8::EpiResid<false, true, false>, pg8::StaticOrder, true, true>(lds, g, S, E, wave);
            GRID_BAR(7);
        }
    }
    if (IN(8) && !fused_tail) {
        const int gt = vcu * (NWAVES * 64) + wave * 64 + dattn::fresh_lane(), NT_ = G * NWAVES * 64;
        const bool bad = (MK_N_LAUNCHES == 1) && (__hip_atomic_load(ctl + CW_BAR + XB_TMO, __ATOMIC_RELAXED, __HIP_MEMORY_SCOPE_AGENT) != 0u);
        const float qnan = __builtin_nanf("");
        for (int i0 = gt; i0 < SEQ * (DM / 4); i0 += 8 * NT_) {
            f32x4 v[8]; float sq[8];
#pragma unroll
            for (int u = 0; u < 8; ++u) { const int i = i0 + u * NT_; if (i < SEQ * (DM / 4)) { v[u] = ((const f32x4*)xres)[i]; sq[u] = ss2[i >> 10]; } }
#pragma unroll
            for (int u = 0; u < 8; ++u) { const int i = i0 + u * NT_; if (i < SEQ * (DM / 4)) { const float rs = 1.0f / sqrtf(sq[u] * (1.0f / 4096.0f) + NORM_EPS);
                const f32x4 gg = ((const f32x4*)final_gain)[i & 1023]; f32x4 r = v[u] * rs * gg; if (bad) r = (f32x4){qnan, qnan, qnan, qnan};
                ((f32x4*)xres)[i] = r; } } }
    }
#undef IN
#undef GRID_BAR
}

extern "C" void kernel_launch(void* const* d_in, const int* in_sizes, int n_in, void* d_out, int out_size, void* d_ws, size_t ws_size, hipStream_t stream) {
    static int grid = 0;
    if (grid == 0) {
        if (n_in != 12 || in_sizes[0] != SEQ * DM || out_size != SEQ * DM || ws_size < WS_END) {
            fprintf(stderr, "kernel_launch: built for 12 inputs, x/out of %d floats, >= %zu bytes of workspace; got n_in %d, in0 %d, out %d, ws %zu; nothing launched\n", SEQ * DM, (size_t)WS_END, n_in, n_in > 0 ? in_sizes[0] : -1, out_size, ws_size); grid = -1; return; }
        int dev = 0, cus = 0, per_cu = 0;
        if (hipGetDevice(&dev) != hipSuccess || hipDeviceGetAttribute(&cus, hipDeviceAttributeMultiprocessorCount, dev) != hipSuccess) { fprintf(stderr, "kernel_launch: device query failed\n"); grid = -1; return; }
        if (hipFuncSetAttribute((const void*)hybrid_fwd, hipFuncAttributeMaxDynamicSharedMemorySize, LDS_BYTES) != hipSuccess) { fprintf(stderr, "kernel_launch: hipFuncSetAttribute failed\n"); grid = -1; return; }
        if (hipOccupancyMaxActiveBlocksPerMultiprocessor(&per_cu, (const void*)hybrid_fwd, NWAVES * 64, LDS_BYTES) != hipSuccess || per_cu < 1)
            fprintf(stderr, "kernel_launch: note: occupancy query reports %d workgroups per CU\n", per_cu);
        (void)hipGetLastError();
        grid = cus;
    }
    if (grid < 0) return;
    if (hipMemsetAsync((char*)d_ws + WS_CTL, 0, CTL_ZERO_BYTES, stream) != hipSuccess) { fprintf(stderr, "kernel_launch: hipMemsetAsync failed\n"); return; }
    Args a{};
    for (int i = 0; i < 12; ++i) a.in[i] = (const float*)d_in[i];
    a.out = (float*)d_out; a.ws = (unsigned char*)d_ws;
    for (int li = 0; li < MK_N_LAUNCHES; ++li) {
        a.ph_lo = (MK_N_LAUNCHES == 1) ? 0 : li; a.ph_hi = (MK_N_LAUNCHES == 1) ? N_PHASES : li + 1;
        hipLaunchKernelGGL(hybrid_fwd, dim3(grid), dim3(NWAVES * 64), LDS_BYTES, stream, a);
        const hipError_t le = hipPeekAtLastError();
        if (le != hipSuccess) { fprintf(stderr, "kernel_launch: launch %d failed: %s\n", li, hipGetErrorName(le)); break; }
    }
}
```
